# Optimizing an MI355X kernel written in HIP

```python
import math
import jax, jax.numpy as jnp
from jax import lax
import numpy as np


D_MODEL = 1024
BATCH = 16
SEQ = 4096
DEPTH = 4
DEC_BATCH = 16
DEC_SEQ = 2048
PAST_LEN = 128

N_META = 16
HEAD_DIM = 64
BLOCK = 128
WINDOW = 128
ROPE_THETA = 10000.0
EPS = 1e-6
NEG_INF = -1e30

A_WIDTH = D_MODEL // 2
A_HEADS = A_WIDTH // HEAD_DIM
A_KV_HEADS = A_HEADS // 4
A_GROUP = A_HEADS // A_KV_HEADS
B_WIDTH = D_MODEL - A_WIDTH
B_VDIM = 2 * HEAD_DIM
B_HEADS = B_WIDTH // B_VDIM
MIX_WIDTH = A_WIDTH + B_WIDTH

A_Q = A_HEADS * HEAD_DIM
A_KV = A_KV_HEADS * HEAD_DIM
B_QK = 2 * B_HEADS * HEAD_DIM
IN_SIZES = (A_Q, A_KV, A_KV, A_WIDTH, B_QK, B_QK, B_WIDTH, B_WIDTH)
IN_WIDTH = A_Q + 2 * A_KV + A_WIDTH + 2 * B_QK + 2 * B_WIDTH

kernel_name = 'hymba_style_window_gqa_diff_attn_encoder'


def rmsnorm(x, g):
    xf = x.astype(jnp.float32)
    y = xf * lax.rsqrt(jnp.mean(xf * xf, axis=-1, keepdims=True) + EPS) * g.astype(jnp.float32)
    return y.astype(x.dtype)


def rope_tables(length):
    inv_freq = 1.0 / (ROPE_THETA ** (jnp.arange(0, HEAD_DIM, 2, dtype=jnp.float32) / HEAD_DIM))
    ang = jnp.arange(length, dtype=jnp.float32)[:, None] * inv_freq[None, :]
    ang = jnp.concatenate([ang, ang], axis=-1)
    return jnp.cos(ang), jnp.sin(ang)


def apply_rope(x, cos, sin):
    shp = (x.shape[1],) + (1,) * (x.ndim - 3) + (HEAD_DIM,)
    c, s = cos.reshape(shp), sin.reshape(shp)
    xf = x.astype(jnp.float32)
    half = HEAD_DIM // 2
    rot = jnp.concatenate([-xf[..., half:], xf[..., :half]], axis=-1)
    return (xf * c + rot * s).astype(x.dtype)


def window_gqa_attention(q, k, v, sink):
    bsz, length = q.shape[0], q.shape[1]
    s = length - N_META
    nb = s // BLOCK
    scale = HEAD_DIM ** -0.5
    q = q.reshape(bsz, length, A_KV_HEADS, A_GROUP, HEAD_DIM)
    qm, qr = q[:, :N_META], q[:, N_META:]
    km, kr = k[:, :N_META], k[:, N_META:]
    vm, vr = v[:, :N_META], v[:, N_META:]
    sink_f = sink.astype(jnp.float32).reshape(A_KV_HEADS, A_GROUP)

    qb = qr.reshape(bsz, nb, BLOCK, A_KV_HEADS, A_GROUP, HEAD_DIM)

    def band(t):
        tp = jnp.pad(t, ((0, 0), (BLOCK, BLOCK), (0, 0), (0, 0)))
        tp = tp.reshape(bsz, nb + 2, BLOCK, A_KV_HEADS, HEAD_DIM)
        return jnp.concatenate([tp[:, :-2], tp[:, 1:-1], tp[:, 2:]], axis=2)

    kb, vb = band(kr), band(vr)
    qi = jnp.arange(nb)[:, None] * BLOCK + jnp.arange(BLOCK)[None, :]
    kj = (jnp.arange(nb)[:, None] - 1) * BLOCK + jnp.arange(3 * BLOCK)[None, :]
    rel = kj[:, None, :] - qi[:, :, None]
    valid = (jnp.abs(rel) <= WINDOW) & (kj[:, None, :] >= 0) & (kj[:, None, :] < s)

    s_meta = jnp.einsum('bnqkgd,bmkd->bnkgqm', qb, km, preferred_element_type=jnp.float32) * scale
    s_band = jnp.einsum('bnqkgd,bnukd->bnkgqu', qb, kb, preferred_element_type=jnp.float32) * scale
    s_band = jnp.where(valid[None, :, None, None], s_band, NEG_INF)
    s_sink = jnp.broadcast_to(sink_f[None, None, :, :, None, None], s_meta.shape[:-1] + (1,))
    p = jax.nn.softmax(jnp.concatenate([s_meta, s_band, s_sink], axis=-1), axis=-1).astype(v.dtype)
    o = (jnp.einsum('bnkgqm,bmkd->bnqkgd', p[..., :N_META], vm)
         + jnp.einsum('bnkgqu,bnukd->bnqkgd', p[..., N_META:N_META + 3 * BLOCK], vb))
    o_real = o.reshape(bsz, s, A_WIDTH)

    kr0, vr0 = kr[:, :BLOCK], vr[:, :BLOCK]
    mpos = jnp.arange(N_META)
    rpos = N_META + jnp.arange(BLOCK)
    mvalid = (rpos[None, :] - mpos[:, None]) <= WINDOW
    sm_meta = jnp.einsum('bmkgd,bnkd->bkgmn', qm, km, preferred_element_type=jnp.float32) * scale
    sm_real = jnp.einsum('bmkgd,bukd->bkgmu', qm, kr0, preferred_element_type=jnp.float32) * scale
    sm_real = jnp.where(mvalid[None, None, None], sm_real, NEG_INF)
    sm_sink = jnp.broadcast_to(sink_f[None, :, :, None, None], sm_meta.shape[:-1] + (1,))
    pm = jax.nn.softmax(jnp.concatenate([sm_meta, sm_real, sm_sink], axis=-1), axis=-1).astype(v.dtype)
    om = (jnp.einsum('bkgmn,bnkd->bmkgd', pm[..., :N_META], vm)
          + jnp.einsum('bkgmu,bukd->bmkgd', pm[..., N_META:N_META + BLOCK], vr0))
    o_meta = om.reshape(bsz, N_META, A_WIDTH)
    return jnp.concatenate([o_meta, o_real], axis=1)


def diff_attention(q, k, v, lam, lambda_init, subln_g):
    bsz, length = q.shape[0], q.shape[1]
    s = length - N_META
    nb = s // BLOCK
    scale = HEAD_DIM ** -0.5

    def attend(qblk):
        sc = jnp.einsum('bqhcd,bkhcd->bhcqk', qblk, k, preferred_element_type=jnp.float32) * scale
        p = jax.nn.softmax(sc, axis=-1)
        a = p[:, :, 0] - lam * p[:, :, 1]
        return jnp.einsum('bhqk,bkhe->bqhe', a.astype(v.dtype), v)

    o_meta = attend(q[:, :N_META])
    qb = q[:, N_META:].reshape(bsz, nb, BLOCK, B_HEADS, 2, HEAD_DIM).swapaxes(0, 1)
    o_real = lax.map(attend, qb).swapaxes(0, 1).reshape(bsz, s, B_HEADS, B_VDIM)
    o = jnp.concatenate([o_meta, o_real], axis=1)
    o = rmsnorm(o, subln_g) * (1.0 - lambda_init)
    return o.reshape(bsz, length, B_WIDTH)


def layer(x, cos, sin, w_in, w_out, pre_g, post_g, sink, lq1, lk1, lq2, lk2, subln_g, lambda_init):
    bsz, length, _ = x.shape
    h = rmsnorm(x, pre_g)
    proj = jnp.einsum('bld,de->ble', h, w_in)
    parts = []
    off = 0
    for size in IN_SIZES:
        parts.append(proj[..., off:off + size])
        off += size
    aq, ak, av, ag, bq, bk, bv, bg = parts

    aq = apply_rope(aq.reshape(bsz, length, A_HEADS, HEAD_DIM), cos, sin)
    ak = apply_rope(ak.reshape(bsz, length, A_KV_HEADS, HEAD_DIM), cos, sin)
    av = av.reshape(bsz, length, A_KV_HEADS, HEAD_DIM)
    oa = window_gqa_attention(aq, ak, av, sink) * jax.nn.silu(ag)

    f32 = jnp.float32
    lam = (jnp.exp(jnp.sum(lq1.astype(f32) * lk1.astype(f32)))
           - jnp.exp(jnp.sum(lq2.astype(f32) * lk2.astype(f32))) + lambda_init)
    bq = apply_rope(bq.reshape(bsz, length, B_HEADS, 2, HEAD_DIM), cos, sin)
    bk = apply_rope(bk.reshape(bsz, length, B_HEADS, 2, HEAD_DIM), cos, sin)
    bv = bv.reshape(bsz, length, B_HEADS, B_VDIM)
    ob = diff_attention(bq, bk, bv, lam, lambda_init, subln_g) * jax.nn.silu(bg)

    o = jnp.einsum('ble,ed->bld', jnp.concatenate([oa, ob], axis=-1), w_out)
    return x + rmsnorm(o, post_g)


def encode(x, meta_tokens, w_in, w_out, pre_norm_g, post_norm_g, sink_logits,
           lambda_q1, lambda_k1, lambda_q2, lambda_k2, subln_g):
    bsz, s, _ = x.shape
    meta = jnp.broadcast_to(meta_tokens[None].astype(x.dtype), (bsz, N_META, D_MODEL))
    h = jnp.concatenate([meta, x], axis=1)
    cos, sin = rope_tables(N_META + s)
    for l in range(DEPTH):
        lambda_init = 0.8 - 0.6 * math.exp(-0.3 * l)
        h = layer(h, cos, sin, w_in[l], w_out[l], pre_norm_g[l], post_norm_g[l], sink_logits[l],
                  lambda_q1[l], lambda_k1[l], lambda_q2[l], lambda_k2[l], subln_g[l], lambda_init)
    return h[:, N_META:]


def setup_inputs(seed: int = 0) -> dict:
    key = jax.random.key(seed)
    ks = jax.random.split(key, 14)
    f32 = jnp.float32
    return {
        'x_prompt': jax.random.normal(ks[0], (BATCH, SEQ, D_MODEL), f32),
        'x_sample': jax.random.normal(ks[1], (DEC_BATCH, DEC_SEQ, D_MODEL), f32),
        'meta_tokens': jax.random.normal(ks[2], (N_META, D_MODEL), f32),
        'w_in': jax.random.normal(ks[3], (DEPTH, D_MODEL, IN_WIDTH), f32) * D_MODEL ** -0.5,
        'w_out': jax.random.normal(ks[4], (DEPTH, MIX_WIDTH, D_MODEL), f32) * MIX_WIDTH ** -0.5,
        'pre_norm_g': 1.0 + 0.02 * jax.random.normal(ks[5], (DEPTH, D_MODEL), f32),
        'post_norm_g': 1.0 + 0.02 * jax.random.normal(ks[6], (DEPTH, D_MODEL), f32),
        'sink_logits': 0.5 * jax.random.normal(ks[7], (DEPTH, A_HEADS), f32),
        'lambda_q1': 0.1 * jax.random.normal(ks[8], (DEPTH, HEAD_DIM), f32),
        'lambda_k1': 0.1 * jax.random.normal(ks[9], (DEPTH, HEAD_DIM), f32),
        'lambda_q2': 0.1 * jax.random.normal(ks[10], (DEPTH, HEAD_DIM), f32),
        'lambda_k2': 0.1 * jax.random.normal(ks[11], (DEPTH, HEAD_DIM), f32),
        'subln_g': 1.0 + 0.02 * jax.random.normal(ks[12], (DEPTH, B_VDIM), f32),
    }


def reference(x_prompt, x_sample, meta_tokens, w_in, w_out, pre_norm_g, post_norm_g, sink_logits,
              lambda_q1, lambda_k1, lambda_q2, lambda_k2, subln_g):
    y_prompt = encode(x_prompt, meta_tokens, w_in, w_out, pre_norm_g, post_norm_g, sink_logits,
                      lambda_q1, lambda_k1, lambda_q2, lambda_k2, subln_g)
    y_sample = encode(x_sample, meta_tokens, w_in, w_out, pre_norm_g, post_norm_g, sink_logits,
                      lambda_q1, lambda_k1, lambda_q2, lambda_k2, subln_g)
    return (y_prompt, y_sample)
```

```cpp
#include <hip/hip_runtime.h>
#include <hip/hip_cooperative_groups.h>
#include <cstdio>
#include <cstdint>
namespace cg = cooperative_groups;

constexpr int DM = 1024, NIN = 3328, NB = 16, DEPTH = 4;
constexpr int LP = 4112, LS = 2064, SP = 4096, SS = 2048;
constexpr int ROWS_P = NB * LP, ROWS_S = NB * LS, MROWS = ROWS_P + ROWS_S;
constexpr float EPS = 1e-6f;
constexpr int C_AQ = 0, C_AK = 512, C_AV = 640, C_AG = 768, C_BQ = 1280, C_BK = 1792, C_BV = 2304, C_BG = 2816;

constexpr size_t MiB = 1u << 20;
constexpr size_t WS_CTL = 0, CTL_BYTES = 65536;
constexpr size_t WS_LAM = 1 * MiB;
constexpr size_t WS_ROPE = 2 * MiB;
constexpr size_t WS_WIN = 4 * MiB;
constexpr size_t WS_WOUT = 30 * MiB;
constexpr size_t WS_METAH = 38 * MiB;
constexpr size_t WS_STASH = 40 * MiB;
constexpr size_t WS_HN = 72 * MiB;
constexpr size_t WS_PROJ = 266 * MiB;
constexpr size_t WS_END = 894 * MiB;

#define LAS __attribute__((address_space(3)))
typedef unsigned short bf16_t;
typedef short bf16x8 __attribute__((ext_vector_type(8)));
typedef short s16x4 __attribute__((ext_vector_type(4)));
typedef float f32x2 __attribute__((ext_vector_type(2)));
typedef float f32x4 __attribute__((ext_vector_type(4)));
typedef float f32x16 __attribute__((ext_vector_type(16)));
typedef unsigned u32x2 __attribute__((ext_vector_type(2)));
typedef unsigned u32x4 __attribute__((ext_vector_type(4)));

__device__ __forceinline__ unsigned cvtpk(float lo, float hi) {
    typedef __bf16 b2 __attribute__((ext_vector_type(2)));
    f32x2 v = {lo, hi}; b2 b = __builtin_convertvector(v, b2); return __builtin_bit_cast(unsigned, b);
}
__device__ __forceinline__ float bf_lo(unsigned u) { return __uint_as_float(u << 16); }
__device__ __forceinline__ float bf_hi(unsigned u) { return __uint_as_float(u & 0xffff0000u); }
__device__ __forceinline__ float wave_sum(float v, int lane) {
#pragma unroll
    for (int o = 1; o < 64; o <<= 1) v += __int_as_float(__builtin_amdgcn_ds_bpermute((lane ^ o) << 2, __float_as_int(v)));
    return v;
}
__device__ __forceinline__ void row_decode(int row, int& g, int& b, int& pos) {
    if (row < ROWS_P) { g = 0; b = row / LP; pos = row - b * LP; }
    else { const int r = row - ROWS_P; g = 1; b = r / LS; pos = r - b * LS; }
}

namespace pg8 {
#define PG8_LAS __attribute__((address_space(3)))
constexpr int BM = 256, BK = 64, HALF = 128, HTB = HALF * BK * 2  , STAGE_BYTES = 8 * HTB, NXCD = 8, WGM = 8;

__host__ __device__ __forceinline__ int lds_byte(int r, int c) { const int st = (r >> 4) * 2 + (c >> 5), rr = r & 15, cc = c & 31, ob = rr * 64 + cc * 2; return st * 1024 + (ob ^ (((ob >> 9) & 1) << 5)); }
__host__ __device__ __forceinline__ void stage_rc(int b, int& R, int& C) { const int st = b / 1024, sb = b % 1024, swz = sb ^ (((sb >> 9) & 1) << 5); R = (st >> 1) * 16 + swz / 64; C = (st & 1) * 32 + (swz % 64) / 2; }
__host__ __device__ __forceinline__ int perm32(int rho) { const int n = rho >> 4, i = rho & 15; return 8 * (i >> 2) + 4 * n + (i & 3); }

struct Unit { int pm, pn; };
struct Gemm { const bf16_t* A; const bf16_t* Bt; int M, N, K; };

struct StaticOrder {
    int nM, nN, nwg, G, c;
    __host__ __device__ void init(int M, int N, int G_, int c_) { nM = M / BM; nN = N / BM; nwg = nM * nN; G = G_; c = c_; }
    __host__ __device__ bool next(int i, Unit& u) const {
        const long L = (long)i * G + c; if (L >= nwg) return false;
        int wgid = (int)L; { const int q = nwg / NXCD, r = nwg % NXCD, xcd = wgid % NXCD, off = wgid / NXCD; wgid = (xcd < r ? xcd * (q + 1) : r * (q + 1) + (xcd - r) * q) + off; }
        const int nig = WGM * nN, gid = wgid / nig, fm = gid * WGM, gsz = (nM - fm) < WGM ? (nM - fm) : WGM;
        u.pm = fm + ((wgid % nig) % gsz); u.pn = (wgid % nig) / gsz; return true;
    }
    __device__ __forceinline__ void a_ready(const Unit&) const {}
    __device__ __forceinline__ void done(const Unit&) const {}
};

template <bool ROPE> struct EpiStore {
    static constexpr bool PERM = true, AFTER_DRAIN = false;
    bf16_t* O; int ldc; const f32x2* rope;
    __device__ __forceinline__ void operator()(const f32x4 (&acc)[2][2][4][2], const Unit& u, int wr, int wc, int fr, int fq) const {
        const int row0 = u.pm * BM + wr * 64 + fr; const int col0 = u.pn * BM + wc * 32 + 8 * fq;
#pragma unroll
        for (int ai = 0; ai < 2; ++ai)
#pragma unroll
            for (int m = 0; m < 4; ++m) {
                const int row = row0 + ai * HALF + m * 16;
                bf16_t* rowp = O + (size_t)row * ldc + col0;
                int pos = 0;
                if (ROPE) { int g, b; row_decode(row, g, b, pos); }
#pragma unroll
                for (int bj = 0; bj < 2; ++bj) {
                    f32x4 v0 = acc[ai][bj][m][0], v1 = acc[ai][bj][m][1];
                    if (ROPE) {
                        const int half = 2 * u.pn + bj;
                        const bool dorope = (half < 5) || (half >= 10 && half < 18);
                        if (dorope) {
                            const int i0 = ((col0 + bj * HALF) & 63) >> 1;
                            const f32x4* rp = (const f32x4*)(rope + (size_t)pos * 32 + i0);
                            const f32x4 cs0 = rp[0], cs1 = rp[1];
                            f32x4 w0, w1;
                            w0[0] = (v0[0] * cs0[0] - v0[1] * cs0[1]); w0[1] = (v0[1] * cs0[0] + v0[0] * cs0[1]);
                            w0[2] = (v0[2] * cs0[2] - v0[3] * cs0[3]); w0[3] = (v0[3] * cs0[2] + v0[2] * cs0[3]);
                            w1[0] = (v1[0] * cs1[0] - v1[1] * cs1[1]); w1[1] = (v1[1] * cs1[0] + v1[0] * cs1[1]);
                            w1[2] = (v1[2] * cs1[2] - v1[3] * cs1[3]); w1[3] = (v1[3] * cs1[2] + v1[2] * cs1[3]);
                            v0 = w0; v1 = w1;
                        }
                    }
                    u32x4 w; w.x = cvtpk(v0[0], v0[1]); w.y = cvtpk(v0[2], v0[3]); w.z = cvtpk(v1[0], v1[1]); w.w = cvtpk(v1[2], v1[3]);
                    if (ROPE) __builtin_nontemporal_store(w, (u32x4*)(rowp + bj * HALF)); else *(u32x4*)(rowp + bj * HALF) = w;
                }
            }
    }
};

template <class Epi, class Sched, bool ALIGN_EPI = false, bool SP2 = false>
__device__ __forceinline__ void gemm_phase(PG8_LAS unsigned char* lds, const Gemm g, const Sched& S, const Epi& E) {
    int tid_ = threadIdx.x; asm volatile("" : "+v"(tid_));
    const int tid = tid_, wid = __builtin_amdgcn_readfirstlane(tid >> 6), lane = tid & 63, wr = wid >> 2, wc = wid & 3, fr = lane & 15, fq = lane >> 4;
    const int K = g.K, nt = K / BK;
    unsigned voffA[2], voffB[2];
#pragma unroll
    for (int i = 0; i < 2; ++i) { int R, C; stage_rc(tid * 16 + i * 8192, R, C); const int Rb = Epi::PERM ? ((R & ~31) + perm32(R & 31)) : R;
        voffA[i] = (unsigned)(R * K + C) * 2u; voffB[i] = (unsigned)(Rb * K + C) * 2u; }
    const size_t kstep = (size_t)(BK * 2);
    const size_t hstep = (size_t)HALF * K * 2;
    const size_t tstep = 2 * hstep;
    const unsigned ldsw = (unsigned)wid * 1024u;
    const int aoff = lds_byte(wr * 64 + fr, fq * 8), boff = lds_byte(wc * 32 + fr, fq * 8);
#define PG8_SA(b, h) (((b) * 2 + (h)) * HTB)
#define PG8_SB(b, h) ((4 + (b) * 2 + (h)) * HTB)
#define PG8_STAGE(bufoff, gbase, voff) do { _Pragma("unroll") for (int _i = 0; _i < 2; ++_i) \
        __builtin_amdgcn_global_load_lds((const unsigned*)((const char*)(gbase) + (voff)[_i]), (PG8_LAS unsigned*)(lds + (bufoff) + ldsw + _i * 8192), 16, 0, 0); } while (0)
#define PG8_LDA(dst, b, h) do { _Pragma("unroll") for (int m = 0; m < 4; ++m) _Pragma("unroll") for (int k = 0; k < 2; ++k) dst[m][k] = *(const PG8_LAS bf16x8*)(lds + PG8_SA(b, h) + aoff + m * 2048 + k * 1024); } while (0)
#define PG8_LDB(dst, b, h) do { _Pragma("unroll") for (int n = 0; n < 2; ++n) _Pragma("unroll") for (int k = 0; k < 2; ++k) dst[n][k] = *(const PG8_LAS bf16x8*)(lds + PG8_SB(b, h) + boff + n * 2048 + k * 1024); } while (0)
#define PG8_MMA(ai, bj, At, Bt) do { __builtin_amdgcn_s_setprio(1); _Pragma("unroll") for (int m = 0; m < 4; ++m) _Pragma("unroll") for (int n = 0; n < 2; ++n) _Pragma("unroll") for (int k = 0; k < 2; ++k) \
        acc[ai][bj][m][n] = __builtin_amdgcn_mfma_f32_16x16x32_bf16(Bt[n][k], At[m][k], acc[ai][bj][m][n], 0, 0, 0); __builtin_amdgcn_s_setprio(0); } while (0)
#define PG8_WAIT_V(n) asm volatile("s_waitcnt vmcnt(" #n ")" ::: "memory")
#define PG8_WAIT_L(n) asm volatile("s_waitcnt lgkmcnt(" #n ")" ::: "memory")
#define PG8_BAR __builtin_amdgcn_s_barrier()
#define PG8_SCHED __builtin_amdgcn_sched_barrier(0)
    Unit cur, nxt; int ui = 0;
    (void)S.next(0, cur);
    f32x4 acc[2][2][4][2];
#pragma unroll
    for (int a = 0; a < 2; ++a)
#pragma unroll
        for (int b = 0; b < 2; ++b)
#pragma unroll
            for (int m = 0; m < 4; ++m)
#pragma unroll
                for (int n = 0; n < 2; ++n) acc[a][b][m][n] = (f32x4){0.f, 0.f, 0.f, 0.f};
    bf16x8 At[4][2], B0[2][2], B1[2][2];
    const char* cA = (const char*)g.A + (size_t)cur.pm * tstep; const char* cB = (const char*)g.Bt + (size_t)cur.pn * tstep;
    S.a_ready(cur);
    if constexpr (SP2) {
        PG8_STAGE(PG8_SB(0, 0), cB, voffB); PG8_STAGE(PG8_SB(0, 1), cB + hstep, voffB); PG8_STAGE(PG8_SA(0, 0), cA, voffA); PG8_STAGE(PG8_SA(0, 1), cA + hstep, voffA);
        if (wr == 1) PG8_BAR;
        PG8_WAIT_V(2); PG8_BAR;
        PG8_STAGE(PG8_SB(1, 0), cB + kstep, voffB); PG8_STAGE(PG8_SA(1, 0), cA + kstep, voffA); PG8_STAGE(PG8_SB(1, 1), cB + hstep + kstep, voffB);
        PG8_WAIT_V(6); PG8_BAR;
    } else {
        PG8_STAGE(PG8_SB(0, 0), cB, voffB); PG8_STAGE(PG8_SA(0, 0), cA, voffA); PG8_STAGE(PG8_SB(0, 1), cB + hstep, voffB); PG8_STAGE(PG8_SA(0, 1), cA + hstep, voffA);
        if (wr == 1) PG8_BAR;
        PG8_WAIT_V(4); PG8_BAR;
        PG8_STAGE(PG8_SB(1, 0), cB + kstep, voffB); PG8_STAGE(PG8_SA(1, 0), cA + kstep, voffA); PG8_STAGE(PG8_SB(1, 1), cB + hstep + kstep, voffB);
        PG8_WAIT_V(6); PG8_BAR;
    }
    for (;;) {
        const bool has_next = S.next(ui + 1, nxt);
        const char* nA = has_next ? (const char*)g.A + (size_t)nxt.pm * tstep : cA; const char* nB = has_next ? (const char*)g.Bt + (size_t)nxt.pn * tstep : cB;
        for (int t = 0; t < nt; t += 2) {
            const bool last = (t == nt - 2);
            const char* a1 = cA + (size_t)(t + 1) * kstep;
            const char* a2 = last ? nA : cA + (size_t)(t + 2) * kstep; const char* b2 = last ? nB : cB + (size_t)(t + 2) * kstep;
            const char* a3 = a2 + kstep; const char* b3 = b2 + kstep;
            if (last && has_next) S.a_ready(nxt);
            if constexpr (SP2) {
            PG8_LDB(B0, 0, 0); PG8_LDB(B1, 0, 1); PG8_SCHED; PG8_LDA(At, 0, 0); PG8_STAGE(PG8_SA(1, 1), a1 + hstep, voffA);
            PG8_WAIT_V(8); PG8_WAIT_L(0); PG8_BAR; PG8_MMA(0, 0, At, B0); PG8_MMA(0, 1, At, B1); PG8_BAR; PG8_SCHED;
            PG8_LDA(At, 0, 1); PG8_STAGE(PG8_SB(0, 0), b2, voffB); PG8_STAGE(PG8_SB(0, 1), b2 + hstep, voffB); PG8_STAGE(PG8_SA(0, 0), a2, voffA);
            PG8_WAIT_V(8); PG8_WAIT_L(0); PG8_BAR; PG8_MMA(1, 0, At, B0); PG8_MMA(1, 1, At, B1); PG8_BAR; PG8_SCHED;
            PG8_LDB(B0, 1, 0); PG8_LDB(B1, 1, 1); PG8_SCHED; PG8_LDA(At, 1, 0); PG8_STAGE(PG8_SA(0, 1), a2 + hstep, voffA);
            PG8_WAIT_V(8); PG8_WAIT_L(0); PG8_BAR; PG8_MMA(0, 0, At, B0); PG8_MMA(0, 1, At, B1); PG8_BAR; PG8_SCHED;
            PG8_LDA(At, 1, 1); PG8_STAGE(PG8_SB(1, 0), b3, voffB); PG8_STAGE(PG8_SB(1, 1), b3 + hstep, voffB); PG8_STAGE(PG8_SA(1, 0), a3, voffA);
            PG8_WAIT_V(8); PG8_WAIT_L(0); PG8_BAR; PG8_MMA(1, 0, At, B0); PG8_MMA(1, 1, At, B1); PG8_BAR; PG8_SCHED;
            } else {
            PG8_LDB(B0, 0, 0); PG8_SCHED; PG8_LDA(At, 0, 0); PG8_STAGE(PG8_SA(1, 1), a1 + hstep, voffA);
            PG8_WAIT_L(8); PG8_BAR; PG8_WAIT_L(0); PG8_MMA(0, 0, At, B0); PG8_BAR; PG8_SCHED;
            PG8_LDB(B1, 0, 1); PG8_STAGE(PG8_SB(0, 0), b2, voffB);
            PG8_BAR; PG8_WAIT_L(0); PG8_MMA(0, 1, At, B1); PG8_BAR;
            PG8_LDA(At, 0, 1); PG8_STAGE(PG8_SA(0, 0), a2, voffA);
            PG8_BAR; PG8_WAIT_L(0); PG8_MMA(1, 0, At, B0); PG8_BAR; PG8_SCHED;
            PG8_STAGE(PG8_SB(0, 1), b2 + hstep, voffB);
            PG8_WAIT_V(6); PG8_BAR; PG8_MMA(1, 1, At, B1); PG8_BAR;
            PG8_LDB(B0, 1, 0); PG8_SCHED; PG8_LDA(At, 1, 0); PG8_STAGE(PG8_SA(0, 1), a2 + hstep, voffA);
            PG8_WAIT_L(8); PG8_BAR; PG8_WAIT_L(0); PG8_MMA(0, 0, At, B0); PG8_BAR; PG8_SCHED;
            PG8_LDB(B1, 1, 1); PG8_STAGE(PG8_SB(1, 0), b3, voffB);
            PG8_BAR; PG8_WAIT_L(0); PG8_MMA(0, 1, At, B1); PG8_BAR;
            PG8_LDA(At, 1, 1); PG8_STAGE(PG8_SA(1, 0), a3, voffA);
            PG8_BAR; PG8_WAIT_L(0); PG8_MMA(1, 0, At, B0); PG8_BAR; PG8_SCHED;
            PG8_STAGE(PG8_SB(1, 1), b3 + hstep, voffB);
            PG8_WAIT_V(6); PG8_BAR; PG8_MMA(1, 1, At, B1); PG8_BAR;
            }
        }
        if constexpr (ALIGN_EPI) { if (wr == 0) PG8_BAR; }
        if constexpr (!Epi::AFTER_DRAIN) { E(acc, cur, wr, wc, fr, fq); S.done(cur); }
        if (!has_next) break;
#pragma unroll
        for (int a = 0; a < 2; ++a)
#pragma unroll
            for (int b = 0; b < 2; ++b)
#pragma unroll
                for (int m = 0; m < 4; ++m)
#pragma unroll
                    for (int n = 0; n < 2; ++n) acc[a][b][m][n] = (f32x4){0.f, 0.f, 0.f, 0.f};
        cur = nxt; cA = nA; cB = nB; ++ui;
        if constexpr (ALIGN_EPI) { if (wr == 1) PG8_BAR; }
    }
    PG8_WAIT_V(0);
    if constexpr (!ALIGN_EPI) { if (wr == 0) PG8_BAR; }
    PG8_BAR;
    if constexpr (Epi::AFTER_DRAIN) { E.fused(acc, cur, wr, wc, fr, fq, lds, wid, lane); S.done(cur); }
#undef PG8_SA
#undef PG8_SB
#undef PG8_STAGE
#undef PG8_LDA
#undef PG8_LDB
#undef PG8_MMA
#undef PG8_WAIT_V
#undef PG8_WAIT_L
#undef PG8_BAR
#undef PG8_SCHED
}
}

namespace att {
typedef short v4i16_t __attribute__((ext_vector_type(4)));
typedef LAS const unsigned char* lcp;
constexpr float NEG = -1.0e30f;
constexpr float LOG2E = 1.4426950408889634f;
constexpr int KP = 144, VP128 = 320, VP64 = 192;
constexpr int KBUF = 64 * KP, VBUF = 64 * VP128;
constexpr int SW_K = 0, SW_V = 24576;
constexpr int OFF_K0 = 0, OFF_K1 = KBUF, OFF_V0 = 2 * KBUF, OFF_V1 = 2 * KBUF + VBUF, OFF_UNIT = 131072;
enum { K_NONE = 0, K_DENSE = 1, K_META = 2, K_BAND = 3, K_METAQ = 4 };

__device__ __forceinline__ int crow(int i, int h) { return (i & 3) + 8 * (i >> 2) + 4 * h; }
__device__ __forceinline__ float swapmax(float v) { auto rr = __builtin_amdgcn_permlane32_swap(__float_as_uint(v), __float_as_uint(v), false, false); return fmaxf(__uint_as_float(rr[0]), __uint_as_float(rr[1])); }
__device__ __forceinline__ float swapsum(float v) { auto rr = __builtin_amdgcn_permlane32_swap(__float_as_uint(v), __float_as_uint(v), false, false); return __uint_as_float(rr[0]) + __uint_as_float(rr[1]); }
__device__ __forceinline__ s16x4 vtr(lcp p) { return __builtin_bit_cast(s16x4, __builtin_amdgcn_ds_read_tr16_b64_v4i16((LAS v4i16_t*)p)); }
__device__ __forceinline__ float max3f(float a, float b, float c) { float r; asm("v_max3_f32 %0, %1, %2, %3" : "=v"(r) : "v"(a), "v"(b), "v"(c)); return r; }
__device__ __forceinline__ float ex2(float x) { return __builtin_amdgcn_exp2f(x); }
__device__ __forceinline__ float silu(float x) { return x * __builtin_amdgcn_rcpf(1.0f + ex2(-x * LOG2E)); }

template <int KIND> __device__ __forceinline__ bool kvalid(int kr, int lim, int qi) {
    if (KIND == K_DENSE) return kr < lim;
    if (KIND == K_META) return kr < 16;
    if (KIND == K_BAND) { const int u = kr - 16; const int d = u - qi; return (unsigned)u < (unsigned)lim && d <= 128 && d >= -128; }
    if (KIND == K_METAQ) { const int u = kr - 16; return kr < 16 || (u < 128 && u <= 112 + qi); }
    return true;
}

template <int DV, int KIND>
__device__ __forceinline__ void tile_compute(f32x16 (&o)[DV / 32], float& m, float& l, const bf16x8 (&qf)[4], lcp kb, lcp vb, int r0, int h, int lim, int qi) {
    constexpr int VP = (DV == 128) ? VP128 : VP64;
    f32x16 s0, s1;
#pragma unroll
    for (int i = 0; i < 16; ++i) { s0[i] = 0.f; s1[i] = 0.f; }
#pragma unroll
    for (int ks = 0; ks < 4; ++ks) {
        const bf16x8 k0 = *(LAS const bf16x8*)(kb + ks * 32);
        const bf16x8 k1 = *(LAS const bf16x8*)(kb + 32 * KP + ks * 32);
        s0 = __builtin_amdgcn_mfma_f32_32x32x16_bf16(k0, qf[ks], s0, 0, 0, 0);
        s1 = __builtin_amdgcn_mfma_f32_32x32x16_bf16(k1, qf[ks], s1, 0, 0, 0);
        if (ks == 1) __builtin_amdgcn_sched_barrier(0);
    }
    if (KIND != K_NONE) {
        int hb = 4 * h + r0; asm volatile("" : "+v"(hb));
#pragma unroll
        for (int i = 0; i < 16; ++i) {
            const int kr = hb + (i & 3) + 8 * (i >> 2);
            s0[i] = kvalid<KIND>(kr, lim, qi) ? s0[i] : NEG;
            s1[i] = kvalid<KIND>(kr + 32, lim, qi) ? s1[i] : NEG;
        }
    }
    float mx = fmaxf(s0[0], s1[0]);
#pragma unroll
    for (int i = 1; i < 16; ++i) mx = fmaxf(mx, fmaxf(s0[i], s1[i]));
    mx = swapmax(mx);
    const float mn = fmaxf(m, mx);
    const float alpha = ex2(m - mn);
    m = mn;
    float rs = 0.f;
#pragma unroll
    for (int i = 0; i < 16; ++i) { s0[i] = ex2(s0[i] - mn); s1[i] = ex2(s1[i] - mn); rs += s0[i] + s1[i]; }
    l = l * alpha + rs;
#pragma unroll
    for (int c = 0; c < DV / 32; ++c)
#pragma unroll
        for (int i = 0; i < 16; ++i) o[c][i] *= alpha;
    bf16x8 pf[4];
    {
        u32x4 w;
        w.x = cvtpk(s0[0], s0[1]); w.y = cvtpk(s0[2], s0[3]); w.z = cvtpk(s0[4], s0[5]); w.w = cvtpk(s0[6], s0[7]); pf[0] = __builtin_bit_cast(bf16x8, w);
        w.x = cvtpk(s0[8], s0[9]); w.y = cvtpk(s0[10], s0[11]); w.z = cvtpk(s0[12], s0[13]); w.w = cvtpk(s0[14], s0[15]); pf[1] = __builtin_bit_cast(bf16x8, w);
        w.x = cvtpk(s1[0], s1[1]); w.y = cvtpk(s1[2], s1[3]); w.z = cvtpk(s1[4], s1[5]); w.w = cvtpk(s1[6], s1[7]); pf[2] = __builtin_bit_cast(bf16x8, w);
        w.x = cvtpk(s1[8], s1[9]); w.y = cvtpk(s1[10], s1[11]); w.z = cvtpk(s1[12], s1[13]); w.w = cvtpk(s1[14], s1[15]); pf[3] = __builtin_bit_cast(bf16x8, w);
    }
    constexpr int NC = DV / 32;
#pragma unroll
    for (int kk = 0; kk < 4; ++kk) {
        s16x4 alo[NC], ahi[NC];
#pragma unroll
        for (int c = 0; c < NC; ++c) { alo[c] = vtr(vb + (16 * kk) * VP + c * 64); ahi[c] = vtr(vb + (16 * kk + 8) * VP + c * 64); }
#pragma unroll
        for (int c = 0; c < NC; ++c) {
            const s16x4 lo = alo[c], hi = ahi[c];
            const bf16x8 a = {lo[0], lo[1], lo[2], lo[3], hi[0], hi[1], hi[2], hi[3]};
            o[c] = __builtin_amdgcn_mfma_f32_32x32x16_bf16(a, pf[kk], o[c], 0, 0, 0);
        }
        __builtin_amdgcn_sched_barrier(0);
    }
}

__device__ __forceinline__ bf16x8 pack8(const f32x16& s, int b) {
    u32x4 w; w.x = cvtpk(s[b], s[b + 1]); w.y = cvtpk(s[b + 2], s[b + 3]); w.z = cvtpk(s[b + 4], s[b + 5]); w.w = cvtpk(s[b + 6], s[b + 7]); return __builtin_bit_cast(bf16x8, w);
}
__device__ __forceinline__ void exp_pv_sw(f32x16 (&o)[4], float m, float& l, f32x16& s0, f32x16& s1, lcp vl, int vB0, int vB1, int q4) {
    const lcp vb0[4] = {vl + vB0 + ((0 ^ q4) << 6), vl + vB0 + ((1 ^ q4) << 6), vl + vB0 + ((2 ^ q4) << 6), vl + vB0 + ((3 ^ q4) << 6)};
    const lcp vb1[4] = {vl + vB1 + ((0 ^ q4) << 6), vl + vB1 + ((1 ^ q4) << 6), vl + vB1 + ((2 ^ q4) << 6), vl + vB1 + ((3 ^ q4) << 6)};
    s16x4 alo[2][4], ahi[2][4];
#define VLOAD(kk, b) do { _Pragma("unroll") for (int c = 0; c < 4; ++c) { alo[b][c] = vtr(vb0[c] + 4096 * (kk)); ahi[b][c] = vtr(vb1[c] + 4096 * (kk)); } } while (0)
#define PVMMA(b, P) do { _Pragma("unroll") for (int c = 0; c < 4; ++c) { const s16x4 lo = alo[b][c], hi = ahi[b][c]; const bf16x8 a = {lo[0], lo[1], lo[2], lo[3], hi[0], hi[1], hi[2], hi[3]}; \
            o[c] = __builtin_amdgcn_mfma_f32_32x32x16_bf16(a, (P), o[c], 0, 0, 0); } } while (0)
#define EXP8(S, b0) do { _Pragma("unroll") for (int i = (b0); i < (b0) + 8; ++i) { S[i] = ex2(S[i]); rs += S[i]; } } while (0)
    float rs = 0.f;
    VLOAD(0, 0);
    EXP8(s0, 0); const bf16x8 p0 = pack8(s0, 0);
    __builtin_amdgcn_sched_barrier(0);
    VLOAD(1, 1); PVMMA(0, p0);
    EXP8(s0, 8); const bf16x8 p1 = pack8(s0, 8);
    __builtin_amdgcn_sched_barrier(0);
    VLOAD(2, 0); PVMMA(1, p1);
    EXP8(s1, 0); const bf16x8 p2 = pack8(s1, 0);
    __builtin_amdgcn_sched_barrier(0);
    VLOAD(3, 1); PVMMA(0, p2);
    EXP8(s1, 8); const bf16x8 p3 = pack8(s1, 8);
    __builtin_amdgcn_sched_barrier(0);
    PVMMA(1, p3);
    l += rs;
    __builtin_amdgcn_sched_barrier(0);
#undef VLOAD
#undef PVMMA
#undef EXP8
}
__device__ __forceinline__ void tile_sw(f32x16 (&o)[4], float& m, float& l, f32x16& negm, const bf16x8 (&qf)[4], lcp kb, int kx, lcp vl, int vB0, int vB1, int q4, int r0, int h, int lim, bool masked, bool first) {
    f32x16 s0, s1;
    bf16x8 kf[4][2];
#pragma unroll
    for (int ks = 0; ks < 4; ++ks) { kf[ks][0] = *(LAS const bf16x8*)(kb + (kx ^ (ks << 5))); kf[ks][1] = *(LAS const bf16x8*)(kb + (kx ^ (ks << 5)) + 4096); }
    __builtin_amdgcn_sched_barrier(0);
#pragma unroll
    for (int ks = 0; ks < 4; ++ks) {
        if (ks == 0) { s0 = __builtin_amdgcn_mfma_f32_32x32x16_bf16(kf[0][0], qf[0], negm, 0, 0, 0); s1 = __builtin_amdgcn_mfma_f32_32x32x16_bf16(kf[0][1], qf[0], negm, 0, 0, 0); }
        else { s0 = __builtin_amdgcn_mfma_f32_32x32x16_bf16(kf[ks][0], qf[ks], s0, 0, 0, 0); s1 = __builtin_amdgcn_mfma_f32_32x32x16_bf16(kf[ks][1], qf[ks], s1, 0, 0, 0); }
    }
    if (masked) {
        int hb = 4 * h + r0; asm volatile("" : "+v"(hb));
#pragma unroll
        for (int i = 0; i < 16; ++i) {
            const int kr = hb + (i & 3) + 8 * (i >> 2);
            s0[i] = kr < lim ? s0[i] : NEG;
            s1[i] = kr + 32 < lim ? s1[i] : NEG;
        }
    }
    asm volatile("s_nop 15" : "+v"(s0), "+v"(s1));
    float mxa = max3f(s0[0], s0[1], s1[0]), mxb = max3f(s0[2], s0[3], s1[1]);
    mxa = max3f(mxa, s1[2], s1[3]);
#pragma unroll
    for (int i = 4; i < 16; i += 4) { mxa = max3f(mxa, s0[i], s0[i + 1]); mxb = max3f(mxb, s0[i + 2], s0[i + 3]); mxa = max3f(mxa, s1[i], s1[i + 1]); mxb = max3f(mxb, s1[i + 2], s1[i + 3]); }
    float mx = max3f(mxa, mxb, mxb);
    mx = swapmax(mx);
    if (first || __builtin_amdgcn_ballot_w64(mx > 8.0f) != 0ull) {
        const float delta = first ? mx : fmaxf(mx, 0.f);
        const float alpha = first ? 1.0f : ex2(-delta);
        m += delta; l *= alpha;
#pragma unroll
        for (int c = 0; c < 4; ++c)
#pragma unroll
            for (int i = 0; i < 16; ++i) asm volatile("v_mul_f32 %0, %1, %0" : "+v"(o[c][i]) : "v"(alpha));
#pragma unroll
        for (int i = 0; i < 16; ++i) { s0[i] -= delta; s1[i] -= delta; negm[i] = -m; }
    }
    exp_pv_sw(o, m, l, s0, s1, vl, vB0, vB1, q4);
}

__device__ __forceinline__ void glds16(const void* gsrc, unsigned lds_dst) {
    unsigned keep;
    asm volatile("s_mov_b32 %0, m0\n\ts_mov_b32 m0, %2\n\ts_nop 0\n\tglobal_load_lds_dwordx4 %1, off\n\ts_mov_b32 m0, %0" : "=&s"(keep) : "v"(gsrc), "s"(lds_dst) : "memory");
}
__device__ __forceinline__ int clampi(int v, int lo, int hi) { return v < lo ? lo : (v > hi ? hi : v); }

__device__ __forceinline__ void diff_unit(LAS unsigned char* lds, const bf16_t* __restrict__ proj, bf16_t* __restrict__ aout, float* __restrict__ stash,
                                          int g, int b, int hh, int qb, const float* __restrict__ lamp, const float* __restrict__ subg) {
    int tid_ = threadIdx.x; asm volatile("" : "+v"(tid_));
    const int tid = tid_, lane = tid & 63, r32 = lane & 31, h = lane >> 5;
    const int w = __builtin_amdgcn_readfirstlane(tid >> 6);
    const int L = g ? LS : LP, brow0 = g ? ROWS_P + b * LS : b * LP, NT = (L + 63) >> 6;
    const bool active = (qb >= 0) || (w == 0);
    const int qrow = (qb >= 0) ? 16 + 256 * qb + 32 * w + r32 : r32;
    const bool rowvalid = (qb >= 0) || (r32 < 16);
    const int kkey = 8 * w + (lane >> 3), kchunk = (lane & 7) ^ ((kkey >> 1) & 7);
    const int vkey0 = 8 * w + (lane >> 4), vkey1 = vkey0 + 4;
    const int vchunk0 = (lane & 15) ^ (((vkey0 & 3) << 2) | ((vkey0 >> 2) & 3)), vchunk1 = (lane & 15) ^ (((vkey1 & 3) << 2) | ((vkey1 >> 2) & 3));
    const bf16_t* kbase = proj + (size_t)brow0 * NIN + C_BK + hh * 128 + kchunk * 8;
    const bf16_t* vbase0 = proj + (size_t)brow0 * NIN + C_BV + hh * 128 + vchunk0 * 8;
    const bf16_t* vbase1 = proj + (size_t)brow0 * NIN + C_BV + hh * 128 + vchunk1 * 8;
    const int fsw = (r32 >> 1) & 7;
    const lcp kb = (lcp)lds + r32 * 128 + ((h ^ (fsw & 1)) * 16);
    const int kx = (fsw >> 1) << 5;
    const int q4 = (lane & 15) >> 2, blk = (lane >> 4) & 1, p4 = lane & 3;
    const int vB0 = (4 * h + q4) * 256 + (((2 * blk + (p4 >> 1)) ^ h) * 16) + 8 * (p4 & 1);
    const int vB1 = (vB0 ^ 32) + 2048;

    f32x16 o[4]; float m = 0.f, l = 0.f; bf16x8 qf[4]; f32x16 negm;
#pragma unroll
    for (int i = 0; i < 16; ++i) negm[i] = 0.f;
#pragma unroll
    for (int c = 0; c < 4; ++c)
#pragma unroll
        for (int i = 0; i < 16; ++i) o[c][i] = 0.f;
    const int total = 2 * NT;
    const unsigned ldsw_k = (unsigned)w * 1024u, ldsw_v = (unsigned)w * 2048u;
    const unsigned lds0 = (unsigned)(size_t)lds;
    const bf16_t* kp = kbase + (size_t)kkey * NIN; const bf16_t* vp0 = vbase0 + (size_t)vkey0 * NIN; const bf16_t* vp1 = vbase1 + (size_t)vkey1 * NIN;
#define DIFF_DMA(tn, kslot, vslot) do { \
        glds16(kp, (unsigned)__builtin_amdgcn_readfirstlane(lds0 + SW_K + (kslot) * 8192 + ldsw_k)); \
        glds16(vp0, (unsigned)__builtin_amdgcn_readfirstlane(lds0 + SW_V + (vslot) * 16384 + ldsw_v)); \
        glds16(vp1, (unsigned)__builtin_amdgcn_readfirstlane(lds0 + SW_V + (vslot) * 16384 + ldsw_v + 1024u)); \
        { const bool wrap_ = ((tn) + 1 == NT);                   \
          const long dk_ = wrap_ ? (long)64 - (long)(NT - 1) * 64 * NIN : (long)64 * NIN, dv_ = wrap_ ? -(long)(NT - 1) * 64 * NIN : (long)64 * NIN; \
          kp += dk_; vp0 += dv_; vp1 += dv_; } } while (0)
    DIFF_DMA(0, 0, 0); DIFF_DMA(1, 1, 1);
    asm volatile("s_waitcnt vmcnt(3)" ::: "memory");
    __builtin_amdgcn_s_barrier(); asm volatile("" ::: "memory");
    int k_cur = 0, k_nn = 2, v_cur = 0, v_nn = 2;
    for (int t = 0; t < total; ++t) {
        const int c = t >= NT ? 1 : 0, tt = t - c * NT;
        if (tt == 0) {
            if (c == 1 && active) {
                const float inv = __builtin_amdgcn_rcpf(swapsum(l));
                int td = tid; asm volatile("" : "+v"(td));
                float* sp = stash + ((size_t)blockIdx.x * 512 + td) * 64;
#pragma unroll
                for (int cc = 0; cc < 4; ++cc)
#pragma unroll
                    for (int g4 = 0; g4 < 4; ++g4) {
                        f32x4 v = {o[cc][4 * g4] * inv, o[cc][4 * g4 + 1] * inv, o[cc][4 * g4 + 2] * inv, o[cc][4 * g4 + 3] * inv};
                        *(f32x4*)(sp + cc * 16 + g4 * 4) = v;
                        o[cc][4 * g4] = 0.f; o[cc][4 * g4 + 1] = 0.f; o[cc][4 * g4 + 2] = 0.f; o[cc][4 * g4 + 3] = 0.f;
                    }
                m = 0.f; l = 0.f;
#pragma unroll
                for (int i = 0; i < 16; ++i) negm[i] = 0.f;
            }
            int qr = qrow; asm volatile("" : "+v"(qr));
            const bf16_t* qp = proj + (size_t)(brow0 + qr) * NIN + C_BQ + hh * 128 + h * 8 + c * 64;
#pragma unroll
            for (int ks = 0; ks < 4; ++ks) qf[ks] = *(const bf16x8*)(qp + ks * 16);
            asm volatile("" : "+v"(qf[0]), "+v"(qf[1]), "+v"(qf[2]), "+v"(qf[3]) :: "memory");
        }
        if (t + 2 < total) DIFF_DMA(t + 2, k_nn, v_nn);
        if (active) {
            const int bo_k = SW_K + k_cur * 8192;
            const lcp vl = (lcp)lds + SW_V + v_cur * 16384;
            tile_sw(o, m, l, negm, qf, kb + bo_k, kx, vl, vB0, vB1, q4, 64 * tt, h, L, tt == NT - 1, tt == 0);
        }
        if (t + 2 < total) asm volatile("s_waitcnt vmcnt(3)" ::: "memory"); else asm volatile("s_waitcnt vmcnt(0)" ::: "memory");
        __builtin_amdgcn_s_barrier(); asm volatile("" ::: "memory");
        k_cur = (k_cur == 2) ? 0 : k_cur + 1; k_nn = (k_nn == 2) ? 0 : k_nn + 1;
        v_cur = (v_cur + 1) & 3; v_nn = (v_nn + 1) & 3;
    }
#undef DIFF_DMA
    if (active) {
        int td = tid, qr = qrow; asm volatile("" : "+v"(td), "+v"(qr));
        const float lam = lamp[0], oml = lamp[1];
        const float inv = __builtin_amdgcn_rcpf(swapsum(l)) * lam;
        const float* sp = stash + ((size_t)blockIdx.x * 512 + td) * 64;
        float ss = 0.f;
#pragma unroll
        for (int cc = 0; cc < 4; ++cc)
#pragma unroll
            for (int g4 = 0; g4 < 4; ++g4) {
                const f32x4 sv = *(const f32x4*)(sp + cc * 16 + g4 * 4);
#pragma unroll
                for (int e = 0; e < 4; ++e) { const float v = sv[e] - o[cc][4 * g4 + e] * inv; o[cc][4 * g4 + e] = v; ss += v * v; }
                if (g4 == 3) __builtin_amdgcn_sched_barrier(0);
            }
        ss = swapsum(ss);
        const float rstd = __builtin_amdgcn_rsqf(ss * (1.0f / 128.0f) + EPS) * oml;
        if (rowvalid) {
            const bf16_t* gp = proj + (size_t)(brow0 + qr) * NIN + C_BG + hh * 128;
            bf16_t* op = aout + (size_t)(brow0 + qr) * DM + 512 + hh * 128;
#pragma unroll
            for (int cc = 0; cc < 4; ++cc)
#pragma unroll
                for (int g4 = 0; g4 < 4; ++g4) {
                    const int d = 32 * cc + 8 * g4 + 4 * h;
                    const u32x2 gt = *(const u32x2*)(gp + d);
                    const f32x4 sg = *(const f32x4*)(subg + d);
                    const float v0 = o[cc][4 * g4 + 0] * rstd * sg[0] * silu(bf_lo(gt.x));
                    const float v1 = o[cc][4 * g4 + 1] * rstd * sg[1] * silu(bf_hi(gt.x));
                    const float v2 = o[cc][4 * g4 + 2] * rstd * sg[2] * silu(bf_lo(gt.y));
                    const float v3 = o[cc][4 * g4 + 3] * rstd * sg[3] * silu(bf_hi(gt.y));
                    u32x2 ov; ov.x = cvtpk(v0, v1); ov.y = cvtpk(v2, v3);
                    *(u32x2*)(op + d) = ov;
                    if (g4 & 1) __builtin_amdgcn_sched_barrier(0);
                }
        }
    }
}

constexpr int WK = 0, WV = 49152;
enum { M_NONE = 0, M_META = 1, M_BAND = 2, M_METAQ = 3 };
__device__ __forceinline__ void wait_vm(int n) {
    switch (n) {
        case 0: asm volatile("s_waitcnt vmcnt(0)" ::: "memory"); break;
        case 2: asm volatile("s_waitcnt vmcnt(2)" ::: "memory"); break;
        case 4: asm volatile("s_waitcnt vmcnt(4)" ::: "memory"); break;
        case 6: asm volatile("s_waitcnt vmcnt(6)" ::: "memory"); break;
        case 8: asm volatile("s_waitcnt vmcnt(8)" ::: "memory"); break;
        default: asm volatile("s_waitcnt vmcnt(10)" ::: "memory"); break;
    }
}
__device__ __forceinline__ void tile_win(f32x16 (&o)[2], float& m, float& l, f32x16& negm, const bf16x8 (&qf)[4], lcp kb, int kx, lcp vl, int vB0, int q1, int r0, int h, int S, int qi, int kind, bool first) {
    f32x16 s0, s1;
    bf16x8 kf[4][2];
#pragma unroll
    for (int ks = 0; ks < 4; ++ks) { kf[ks][0] = *(LAS const bf16x8*)(kb + (kx ^ (ks << 5))); kf[ks][1] = *(LAS const bf16x8*)(kb + (kx ^ (ks << 5)) + 4096); }
    __builtin_amdgcn_sched_barrier(0);
#pragma unroll
    for (int ks = 0; ks < 4; ++ks) {
        if (ks == 0) { s0 = __builtin_amdgcn_mfma_f32_32x32x16_bf16(kf[0][0], qf[0], negm, 0, 0, 0); s1 = __builtin_amdgcn_mfma_f32_32x32x16_bf16(kf[0][1], qf[0], negm, 0, 0, 0); }
        else { s0 = __builtin_amdgcn_mfma_f32_32x32x16_bf16(kf[ks][0], qf[ks], s0, 0, 0, 0); s1 = __builtin_amdgcn_mfma_f32_32x32x16_bf16(kf[ks][1], qf[ks], s1, 0, 0, 0); }
    }
    if (kind != M_NONE) {
        int hb = 4 * h + r0; asm volatile("" : "+v"(hb));
        if (kind == M_META) {
#pragma unroll
            for (int i = 0; i < 16; ++i) { const int kr = hb + (i & 3) + 8 * (i >> 2); s0[i] = kvalid<K_META>(kr, S, qi) ? s0[i] : NEG; s1[i] = kvalid<K_META>(kr + 32, S, qi) ? s1[i] : NEG; }
        } else if (kind == M_BAND) {
#pragma unroll
            for (int i = 0; i < 16; ++i) { const int kr = hb + (i & 3) + 8 * (i >> 2); s0[i] = kvalid<K_BAND>(kr, S, qi) ? s0[i] : NEG; s1[i] = kvalid<K_BAND>(kr + 32, S, qi) ? s1[i] : NEG; }
        } else {
#pragma unroll
            for (int i = 0; i < 16; ++i) { const int kr = hb + (i & 3) + 8 * (i >> 2); s0[i] = kvalid<K_METAQ>(kr, S, qi) ? s0[i] : NEG; s1[i] = kvalid<K_METAQ>(kr + 32, S, qi) ? s1[i] : NEG; }
        }
    }
    asm volatile("s_nop 15" : "+v"(s0), "+v"(s1));
    float mxa = max3f(s0[0], s0[1], s1[0]), mxb = max3f(s0[2], s0[3], s1[1]);
    mxa = max3f(mxa, s1[2], s1[3]);
#pragma unroll
    for (int i = 4; i < 16; i += 4) { mxa = max3f(mxa, s0[i], s0[i + 1]); mxb = max3f(mxb, s0[i + 2], s0[i + 3]); mxa = max3f(mxa, s1[i], s1[i + 1]); mxb = max3f(mxb, s1[i + 2], s1[i + 3]); }
    float mx = max3f(mxa, mxb, mxb);
    mx = swapmax(mx);
    if (first || __builtin_amdgcn_ballot_w64(mx > 8.0f) != 0ull) {
        const float delta = first ? mx : fmaxf(mx, 0.f);
        const float alpha = first ? 1.0f : ex2(-delta);
        m += delta; l *= alpha;
#pragma unroll
        for (int c = 0; c < 2; ++c)
#pragma unroll
            for (int i = 0; i < 16; ++i) asm volatile("v_mul_f32 %0, %1, %0" : "+v"(o[c][i]) : "v"(alpha));
#pragma unroll
        for (int i = 0; i < 16; ++i) { s0[i] -= delta; s1[i] -= delta; negm[i] = -m; }
    }
    const lcp vb0[2] = {vl + vB0 + ((0 ^ q1) << 6), vl + vB0 + ((1 ^ q1) << 6)};
    s16x4 alo[2][2], ahi[2][2];
#define VLOAD(kk, b) do { _Pragma("unroll") for (int c = 0; c < 2; ++c) { alo[b][c] = vtr(vb0[c] + 2048 * (kk)); ahi[b][c] = vtr(vb0[c] + 2048 * (kk) + 1024); } } while (0)
#define PVMMA(b, P) do { _Pragma("unroll") for (int c = 0; c < 2; ++c) { const s16x4 lo = alo[b][c], hi = ahi[b][c]; const bf16x8 a = {lo[0], lo[1], lo[2], lo[3], hi[0], hi[1], hi[2], hi[3]}; \
            o[c] = __builtin_amdgcn_mfma_f32_32x32x16_bf16(a, (P), o[c], 0, 0, 0); } } while (0)
#define EXP8(S_, b0) do { _Pragma("unroll") for (int i = (b0); i < (b0) + 8; ++i) { S_[i] = ex2(S_[i]); rs += S_[i]; } } while (0)
    float rs = 0.f;
    VLOAD(0, 0);
    EXP8(s0, 0); const bf16x8 p0 = pack8(s0, 0);
    __builtin_amdgcn_sched_barrier(0);
    VLOAD(1, 1); PVMMA(0, p0);
    EXP8(s0, 8); const bf16x8 p1 = pack8(s0, 8);
    __builtin_amdgcn_sched_barrier(0);
    VLOAD(2, 0); PVMMA(1, p1);
    EXP8(s1, 0); const bf16x8 p2 = pack8(s1, 0);
    __builtin_amdgcn_sched_barrier(0);
    VLOAD(3, 1); PVMMA(0, p2);
    EXP8(s1, 8); const bf16x8 p3 = pack8(s1, 8);
    __builtin_amdgcn_sched_barrier(0);
    PVMMA(1, p3);
    l += rs;
    __builtin_amdgcn_sched_barrier(0);
#undef VLOAD
#undef PVMMA
#undef EXP8
}
__device__ __forceinline__ void win_unit(LAS unsigned char* lds, const bf16_t* __restrict__ proj, bf16_t* __restrict__ aout,
                                         int g, int b, int kh, int qb, const float* __restrict__ sink) {
    int tid_ = threadIdx.x; asm volatile("" : "+v"(tid_));
    const int tid = tid_, lane = tid & 63, r32 = lane & 31, h = lane >> 5;
    const int w = __builtin_amdgcn_readfirstlane(tid >> 6);
    const int L = g ? LS : LP, S = g ? SS : SP, brow0 = g ? ROWS_P + b * LS : b * LP;
    const bool real = qb >= 0;
    const bool active = real || (w < 2);
    const int ntile = real ? 6 : 3;
    const int hq = real ? 4 * kh + (w & 3) : 4 * kh + 2 * (w & 1) + (r32 >> 4);
    const int qi = real ? 64 * qb + 32 * (w >> 2) + r32 : (r32 & 15);
    const int qrow = real ? 16 + qi : qi;
    const int band0 = 16 + 64 * qb - 128;
    const int kkey = 8 * w + (lane >> 3), kchunk = (lane & 7) ^ ((kkey >> 1) & 7), vchunk = (lane & 7) ^ (((kkey >> 1) & 1) << 2);
    const bf16_t* kbase = proj + (size_t)brow0 * NIN + C_AK + kh * 64 + kchunk * 8;
    const bf16_t* vbase = proj + (size_t)brow0 * NIN + C_AV + kh * 64 + vchunk * 8;
    const int fsw = (r32 >> 1) & 7;
    const lcp kb = (lcp)lds + WK + r32 * 128 + ((h ^ (fsw & 1)) * 16);
    const int kx = (fsw >> 1) << 5;
    const int q4 = (lane & 15) >> 2, blk = (lane >> 4) & 1, p4 = lane & 3;
    const int vB0 = (4 * h + q4) * 128 + (2 * blk + (p4 >> 1)) * 16 + 8 * (p4 & 1);
    const unsigned lds0 = (unsigned)(size_t)lds;

    f32x16 o[2]; float m = 0.f, l = 0.f; bf16x8 qf[4]; f32x16 negm;
#pragma unroll
    for (int i = 0; i < 16; ++i) { o[0][i] = 0.f; o[1][i] = 0.f; negm[i] = 0.f; }
    {
        const bf16_t* qptr = proj + (size_t)(brow0 + qrow) * NIN + C_AQ + hq * 64 + h * 8;
#pragma unroll
        for (int ks = 0; ks < 4; ++ks) qf[ks] = *(const bf16x8*)(qptr + ks * 16);
        asm volatile("" : "+v"(qf[0]), "+v"(qf[1]), "+v"(qf[2]), "+v"(qf[3]) :: "memory");
    }
#define WIN_R0(t) (real ? ((t) == 0 ? 0 : band0 + 64 * ((t) - 1)) : 64 * (t))
    for (int t = 0; t < ntile; ++t) {
        const size_t ro = (size_t)clampi(WIN_R0(t) + kkey, 0, L - 1) * NIN;
        glds16(kbase + ro, (unsigned)__builtin_amdgcn_readfirstlane(lds0 + WK + t * 8192 + w * 1024));
        glds16(vbase + ro, (unsigned)__builtin_amdgcn_readfirstlane(lds0 + WV + t * 8192 + w * 1024));
    }
    for (int t = 0; t < ntile; ++t) {
        wait_vm(2 * (ntile - 1 - t));
        __builtin_amdgcn_s_barrier(); asm volatile("" ::: "memory");
        if (active) {
            const int r0 = WIN_R0(t);
            int kind;
            if (!real) kind = M_METAQ;
            else if (t == 0) kind = M_META;
            else {
                const int u0 = r0 - 16, q0 = 64 * qb;
                kind = (u0 >= 0 && u0 + 63 < S && u0 + 63 - q0 <= 128 && q0 + 63 - u0 <= 128) ? M_NONE : M_BAND;
            }
            tile_win(o, m, l, negm, qf, kb + t * 8192, kx, (lcp)lds + WV + t * 8192, vB0, q4 >> 1, r0, h, S, qi, kind, t == 0);
        }
    }
#undef WIN_R0
    __builtin_amdgcn_s_barrier(); asm volatile("" ::: "memory");
    if (active) {
        int qr = qrow; asm volatile("" : "+v"(qr));
        const float lt = swapsum(l) + ex2(sink[hq] * LOG2E - m);
        const float inv = __builtin_amdgcn_rcpf(lt);
        const bf16_t* gp = proj + (size_t)(brow0 + qr) * NIN + C_AG + hq * 64;
        bf16_t* op = aout + (size_t)(brow0 + qr) * DM + hq * 64;
#pragma unroll
        for (int cc = 0; cc < 2; ++cc)
#pragma unroll
            for (int g4 = 0; g4 < 4; ++g4) {
                const int d = 32 * cc + 8 * g4 + 4 * h;
                const u32x2 gt = *(const u32x2*)(gp + d);
                const float v0 = o[cc][4 * g4 + 0] * inv * silu(bf_lo(gt.x));
                const float v1 = o[cc][4 * g4 + 1] * inv * silu(bf_hi(gt.x));
                const float v2 = o[cc][4 * g4 + 2] * inv * silu(bf_lo(gt.y));
                const float v3 = o[cc][4 * g4 + 3] * inv * silu(bf_hi(gt.y));
                u32x2 ov; ov.x = cvtpk(v0, v1); ov.y = cvtpk(v2, v3);
                *(u32x2*)(op + d) = ov;
            }
    }
}

__device__ __forceinline__ void attn_phase(LAS unsigned char* lds, const bf16_t* proj, bf16_t* aout, float* stash, unsigned* ctr, bool last,
                                           const float* lamp, const float* subg, const float* sink) {
    const int nP = last ? 16 : 17, nS = last ? 8 : 9;
    const int e1 = 8 * nP, e2 = e1 + 8 * nS, e3 = e2 + 256, e4 = e3 + 128, e5 = e4 + (last ? 0 : 8);
    LAS volatile int* su = (LAS volatile int*)(lds + OFF_UNIT);
    const int xcd = (int)(__builtin_amdgcn_s_getreg((3 << 11) | 20) & 7u);
    int kq = 0;
    for (;;) {
        if (threadIdx.x == 0) {
            int u = -1, x = 0;
            while (kq < 8) {
                x = (xcd + kq) & 7;
                int z; asm volatile("v_mov_b32 %0, 0" : "=v"(z));
                const int v = (int)__hip_atomic_fetch_add(ctr + 16 * x + z, 1u, __ATOMIC_RELAXED, __HIP_MEMORY_SCOPE_AGENT);
                if (v < e5) { u = v; break; }
                ++kq;
            }
            su[0] = u; su[1] = x;
        }
        __syncthreads();
        const int u = su[0], x = su[1];
        __syncthreads();
        if (u < 0) break;
        if (u < e2) {
            int g, bh, qb;
            if (u < e1) { const int j = u / nP, r = u - j * nP; g = 0; bh = x + 8 * j; qb = r < 16 ? r : -1; }
            else { const int v = u - e1, j = v / nS, r = v - j * nS; g = 1; bh = x + 8 * j; qb = r < 8 ? r : -1; }
            diff_unit(lds, proj, aout, stash, g, bh >> 2, bh & 3, qb, lamp, subg);
        } else {
            int g, bk, qb;
            if (u < e3) { const int v = u - e2; g = 0; bk = x + 8 * (v >> 6); qb = v & 63; }
            else if (u < e4) { const int v = u - e3; g = 1; bk = x + 8 * (v >> 5); qb = v & 31; }
            else { const int v = u - e4; g = v >> 2; bk = x + 8 * (v & 3); qb = -1; }
            win_unit(lds, proj, aout, g, bk >> 1, bk & 1, qb, sink);
        }
    }
}
}

constexpr int NWAVES = 8;
constexpr int LDS_BYTES = 147456;
constexpr int N_PHASES = 1 + 4 * DEPTH;

__device__ __forceinline__ void grid_bar(unsigned* cnt, unsigned target) {
    asm volatile("s_waitcnt vmcnt(0)" ::: "memory");
    __syncthreads();
    if (threadIdx.x == 0) {
        __builtin_amdgcn_fence(__ATOMIC_RELEASE, "agent");
        asm volatile("s_waitcnt vmcnt(0)" ::: "memory");
        int z; asm volatile("v_mov_b32 %0, 0" : "=v"(z));
        __hip_atomic_fetch_add(cnt + z, 1u, __ATOMIC_RELAXED, __HIP_MEMORY_SCOPE_AGENT);
        while (__hip_atomic_load(cnt, __ATOMIC_RELAXED, __HIP_MEMORY_SCOPE_AGENT) < target) __builtin_amdgcn_s_sleep(2);
        __builtin_amdgcn_fence(__ATOMIC_ACQUIRE, "agent");
        asm volatile("s_waitcnt vmcnt(0)" ::: "memory");
    }
    __syncthreads();
}

struct Args { const float* in[13]; float* out; unsigned char* ws; int ph_lo, ph_hi; };

__device__ __forceinline__ int src_col(int n) {
    const bool r = (n < C_AV) || (n >= C_BQ && n < C_BV);
    if (!r) return n;
    const int w = n & 63;
    return (n & ~63) + (w >> 1) + 32 * (w & 1);
}
__device__ __forceinline__ void transpose_item(const float* __restrict__ W, int N, bf16_t* __restrict__ WT, LAS float* scr, int item, int lane, bool permute) {
    const int nblk = N / 32, kb = item / nblk, nb = item % nblk, k0 = 64 * kb, n0 = 32 * nb;
    const int sc = permute ? src_col(n0 + (lane & 31)) : n0 + (lane & 31);
#pragma unroll 8
    for (int i = 0; i < 32; ++i) { const int kk = 2 * i + (lane >> 5); scr[kk * 33 + (lane & 31)] = W[(size_t)(k0 + kk) * N + sc]; }
    asm volatile("s_waitcnt lgkmcnt(0)" ::: "memory");
    const int c = lane & 7;
#pragma unroll
    for (int j = 0; j < 4; ++j) {
        const int n = (lane >> 3) + 8 * j; const LAS float* s = scr + (8 * c) * 33 + n;
        const int nn = n0 + n; const float sc = (permute && (nn < C_AK || (nn >= C_BQ && nn < C_BK))) ? 0.125f * 1.4426950408889634f : 1.0f;
        u32x4 o; o.x = cvtpk(s[0 * 33] * sc, s[1 * 33] * sc); o.y = cvtpk(s[2 * 33] * sc, s[3 * 33] * sc); o.z = cvtpk(s[4 * 33] * sc, s[5 * 33] * sc); o.w = cvtpk(s[6 * 33] * sc, s[7 * 33] * sc);
        *(u32x4*)(WT + (size_t)nn * 1024 + k0 + 8 * c) = o;
    }
    asm volatile("s_waitcnt lgkmcnt(0)" ::: "memory");
}

__device__ __forceinline__ const float* h0_row(const Args& a, int g, int b, int pos) {
    if (pos < 16) return a.in[2] + (size_t)pos * DM;
    return (g ? a.in[1] : a.in[0]) + ((size_t)b * (g ? SS : SP) + (pos - 16)) * DM;
}

__device__ __forceinline__ void prologue(const Args& a, LAS unsigned char* lds) {
    int tid_ = threadIdx.x; asm volatile("" : "+v"(tid_));
    const int tid = tid_, lane = tid & 63, wave = tid >> 6;
    const int gw = blockIdx.x * NWAVES + wave, NGW = gridDim.x * NWAVES;
    unsigned char* ws = a.ws;
    LAS float* scr = (LAS float*)(lds + wave * 16384);
    constexpr int I_IN = 16 * (NIN / 32), I_OUT = 16 * (DM / 32);
    constexpr int NITEMS = DEPTH * (I_IN + I_OUT);
    for (int it = gw; it < NITEMS; it += NGW) {
        if (it < DEPTH * I_IN) { const int l = it / I_IN, r = it - l * I_IN;
            transpose_item(a.in[3] + (size_t)l * DM * NIN, NIN, (bf16_t*)(ws + WS_WIN) + (size_t)l * NIN * DM, scr, r, lane, true); }
        else { const int q = it - DEPTH * I_IN, l = q / I_OUT, r = q - l * I_OUT;
            transpose_item(a.in[4] + (size_t)l * DM * DM, DM, (bf16_t*)(ws + WS_WOUT) + (size_t)l * DM * DM, scr, r, lane, false); }
    }
    {
        f32x2* rope = (f32x2*)(ws + WS_ROPE);
        for (int e = blockIdx.x * 512 + tid; e < LP * 32; e += gridDim.x * 512) {
            const int pos = e >> 5, i = e & 31;
            const float inv_freq = __builtin_amdgcn_exp2f(-(float)i * (13.287712379549449f / 32.0f));
            const float ang = (float)pos * inv_freq;
            const float rev = ang * 0.15915494309189535f;
            const float fr = rev - floorf(rev);
            f32x2 cs; cs.x = __builtin_amdgcn_cosf(fr); cs.y = __builtin_amdgcn_sinf(fr);
            rope[e] = cs;
        }
    }
    {
        const float* pg = a.in[5];
        bf16_t* hn = (bf16_t*)(ws + WS_HN);
        for (int row0 = gw; row0 < MROWS; row0 += 2 * NGW) {
            f32x4 v[2][4]; bool live[2]; int rows[2];
#pragma unroll
            for (int u = 0; u < 2; ++u) {
                const int row = row0 + u * NGW; live[u] = row < MROWS; rows[u] = live[u] ? row : MROWS - 1;
                int g, b, pos; row_decode(rows[u], g, b, pos);
                const float* x = h0_row(a, g, b, pos);
#pragma unroll
                for (int j = 0; j < 2; ++j) { v[u][2 * j] = *(const f32x4*)(x + 512 * j + lane * 8); v[u][2 * j + 1] = *(const f32x4*)(x + 512 * j + lane * 8 + 4); }
            }
#pragma unroll
            for (int u = 0; u < 2; ++u) {
                if (!live[u]) continue;
                float ss = 0.f;
#pragma unroll
                for (int j = 0; j < 4; ++j) ss += (v[u][j][0] * v[u][j][0] + v[u][j][1] * v[u][j][1]) + (v[u][j][2] * v[u][j][2] + v[u][j][3] * v[u][j][3]);
                const float rstd = __builtin_amdgcn_rsqf(wave_sum(ss, lane) * (1.0f / DM) + EPS);
#pragma unroll
                for (int j = 0; j < 2; ++j) {
                    const f32x4 g0 = *(const f32x4*)(pg + 512 * j + lane * 8), g1 = *(const f32x4*)(pg + 512 * j + lane * 8 + 4);
                    const f32x4 a0 = v[u][2 * j] * rstd * g0, a1 = v[u][2 * j + 1] * rstd * g1;
                    u32x4 o; o.x = cvtpk(a0[0], a0[1]); o.y = cvtpk(a0[2], a0[3]); o.z = cvtpk(a1[0], a1[1]); o.w = cvtpk(a1[2], a1[3]);
                    *(u32x4*)(hn + (size_t)rows[u] * DM + 512 * j + lane * 8) = o;
                }
            }
        }
    }
    {
        u32x4* pad = (u32x4*)(ws + WS_PROJ + (size_t)MROWS * NIN * 2);
        const u32x4 z = {0u, 0u, 0u, 0u};
        for (int e = blockIdx.x * 512 + tid; e < (64 * NIN * 2) / 16; e += gridDim.x * 512) pad[e] = z;
    }
    if (blockIdx.x == 0 && wave == 0) {
        float* lamv = (float*)(ws + WS_LAM);
        for (int l = 0; l < DEPTH; ++l) {
            const float s1 = wave_sum(a.in[8][l * 64 + lane] * a.in[9][l * 64 + lane], lane);
            const float s2 = wave_sum(a.in[10][l * 64 + lane] * a.in[11][l * 64 + lane], lane);
            const float li = 0.8f - 0.6f * expf(-0.3f * (float)l);
            if (lane == 0) { lamv[2 * l] = expf(s1) - expf(s2) + li; lamv[2 * l + 1] = 1.0f - li; }
        }
    }
}

struct NormRow { const float* hold; float* hnew; u32x4 r[2]; f32x4 ho[4]; bool live; bool meta; };
__device__ __forceinline__ void norm_load(const Args& a, int l, bool last, int row, int lane, const bf16_t* ob, float* metah, NormRow& R) {
    R.live = row < MROWS;
    const int rr = R.live ? row : MROWS - 1;
    int g, b, pos; row_decode(rr, g, b, pos);
    if (last && pos < 16) R.live = false;
    R.meta = pos < 16;
    if (pos < 16) { R.hnew = metah + ((size_t)(g * NB + b) * 16 + pos) * DM; R.hold = (l == 0) ? a.in[2] + (size_t)pos * DM : R.hnew; }
    else { const size_t off = (g ? (size_t)NB * SP * DM : 0) + ((size_t)b * (g ? SS : SP) + (pos - 16)) * DM; R.hnew = a.out + off;
           R.hold = (l == 0) ? (g ? a.in[1] : a.in[0]) + ((size_t)b * (g ? SS : SP) + (pos - 16)) * DM : R.hnew; }
#pragma unroll
    for (int j = 0; j < 2; ++j) R.r[j] = *(const u32x4*)(ob + (size_t)rr * DM + 512 * j + lane * 8);
    if (l == 0 || R.meta) {
#pragma unroll
        for (int j = 0; j < 4; ++j) R.ho[j] = *(const f32x4*)(R.hold + 512 * (j >> 1) + lane * 8 + 4 * (j & 1));
    } else {
        const bf16_t* hb = (const bf16_t*)R.hold;
#pragma unroll
        for (int j = 0; j < 2; ++j) {
            const u32x4 q = *(const u32x4*)(hb + 512 * j + lane * 8);
            R.ho[2 * j] = (f32x4){bf_lo(q.x), bf_hi(q.x), bf_lo(q.y), bf_hi(q.y)};
            R.ho[2 * j + 1] = (f32x4){bf_lo(q.z), bf_hi(q.z), bf_lo(q.w), bf_hi(q.w)};
        }
    }
}
__device__ __forceinline__ void norm_compute(const NormRow& R, int row, int lane, bool last, const f32x4 (&pgv)[4], const f32x4 (&prv)[4], bf16_t* hn) {
    if (!R.live) return;
    f32x4 ov[4]; float ss = 0.f;
#pragma unroll
    for (int j = 0; j < 2; ++j) {
        const u32x4 r = R.r[j];
        ov[2 * j] = (f32x4){bf_lo(r.x), bf_hi(r.x), bf_lo(r.y), bf_hi(r.y)};
        ov[2 * j + 1] = (f32x4){bf_lo(r.z), bf_hi(r.z), bf_lo(r.w), bf_hi(r.w)};
    }
#pragma unroll
    for (int j = 0; j < 4; ++j) ss += (ov[j][0] * ov[j][0] + ov[j][1] * ov[j][1]) + (ov[j][2] * ov[j][2] + ov[j][3] * ov[j][3]);
    const float rstd = __builtin_amdgcn_rsqf(wave_sum(ss, lane) * (1.0f / DM) + EPS);
    f32x4 hv[4]; float s2 = 0.f;
#pragma unroll
    for (int j = 0; j < 4; ++j) {
        const int c0 = 512 * (j >> 1) + lane * 8 + 4 * (j & 1);
        hv[j] = R.ho[j] + ov[j] * rstd * pgv[j];
        s2 += (hv[j][0] * hv[j][0] + hv[j][1] * hv[j][1]) + (hv[j][2] * hv[j][2] + hv[j][3] * hv[j][3]);
    }
    if (last || R.meta) {
#pragma unroll
        for (int j = 0; j < 4; ++j) { if (last) __builtin_nontemporal_store(hv[j], (f32x4*)(R.hnew + 512 * (j >> 1) + lane * 8 + 4 * (j & 1))); else *(f32x4*)(R.hnew + 512 * (j >> 1) + lane * 8 + 4 * (j & 1)) = hv[j]; }
    } else {
        bf16_t* hb = (bf16_t*)R.hnew;
#pragma unroll
        for (int j = 0; j < 2; ++j) {
            u32x4 o; o.x = cvtpk(hv[2 * j][0], hv[2 * j][1]); o.y = cvtpk(hv[2 * j][2], hv[2 * j][3]); o.z = cvtpk(hv[2 * j + 1][0], hv[2 * j + 1][1]); o.w = cvtpk(hv[2 * j + 1][2], hv[2 * j + 1][3]);
            __builtin_nontemporal_store(o, (u32x4*)(hb + 512 * j + lane * 8));
        }
    }
    if (!last) {
        const float rstd2 = __builtin_amdgcn_rsqf(wave_sum(s2, lane) * (1.0f / DM) + EPS);
#pragma unroll
        for (int j = 0; j < 2; ++j) {
            const int c0 = 512 * j + lane * 8;
            const f32x4 a0 = hv[2 * j] * rstd2 * prv[2 * j], a1 = hv[2 * j + 1] * rstd2 * prv[2 * j + 1];
            u32x4 o; o.x = cvtpk(a0[0], a0[1]); o.y = cvtpk(a0[2], a0[3]); o.z = cvtpk(a1[0], a1[1]); o.w = cvtpk(a1[2], a1[3]);
            *(u32x4*)(hn + (size_t)row * DM + c0) = o;
        }
    }
}
__device__ __forceinline__ void norm_phase(const Args& a, int l) {
    int tid_ = threadIdx.x; asm volatile("" : "+v"(tid_));
    const int tid = tid_, lane = tid & 63, wave = tid >> 6;
    const int gw = blockIdx.x * NWAVES + wave, NGW = gridDim.x * NWAVES;
    unsigned char* ws = a.ws;
    const bf16_t* ob = (const bf16_t*)(ws + WS_PROJ);
    bf16_t* hn = (bf16_t*)(ws + WS_HN);
    float* metah = (float*)(ws + WS_METAH);
    const float* postg = a.in[6] + (size_t)l * DM;
    const bool last = (l == DEPTH - 1);
    const float* preg = a.in[5] + (size_t)(last ? l : l + 1) * DM;
    f32x4 pgv[4], prv[4];
#pragma unroll
    for (int j = 0; j < 4; ++j) { const int c0 = 512 * (j >> 1) + lane * 8 + 4 * (j & 1); pgv[j] = *(const f32x4*)(postg + c0); prv[j] = *(const f32x4*)(preg + c0); }
    for (int row = gw; row < MROWS; row += 2 * NGW) {
        NormRow A, B;
        norm_load(a, l, last, row, lane, ob, metah, A);
        norm_load(a, l, last, row + NGW, lane, ob, metah, B);
        norm_compute(A, row, lane, last, pgv, prv, hn);
        norm_compute(B, row + NGW, lane, last, pgv, prv, hn);
    }
}

__global__ void __launch_bounds__(NWAVES * 64, 2) fwd_kernel(Args a) {
    extern __shared__ __attribute__((aligned(16))) unsigned char lds_raw[];
    LAS unsigned char* lds = (LAS unsigned char*)lds_raw;
    unsigned char* ws = a.ws;
#define IN(k) true
#define SEAM(k) do { ++nbar; grid_bar((unsigned*)(ws + WS_CTL) + 1024, nbar * gridDim.x); } while (0)
    unsigned nbar = 0;
    if (IN(0)) { prologue(a, lds); }
    cg::this_grid().sync();
    for (int l = 0; l < DEPTH; ++l) {
        const int p0 = 1 + 4 * l;
        if (IN(p0)) {
            pg8::Gemm g{(const bf16_t*)(ws + WS_HN), (const bf16_t*)(ws + WS_WIN) + (size_t)l * NIN * DM, MROWS, NIN, DM};
            pg8::StaticOrder S; S.init(MROWS, NIN, (int)gridDim.x, (int)blockIdx.x);
            pg8::EpiStore<true> E{(bf16_t*)(ws + WS_PROJ), NIN, (const f32x2*)(ws + WS_ROPE)};
            pg8::gemm_phase<pg8::EpiStore<true>, pg8::StaticOrder, true, true>(lds, g, S, E);
        }
        SEAM(p0);
        if (IN(p0 + 1)) {
            att::attn_phase(lds, (const bf16_t*)(ws + WS_PROJ), (bf16_t*)(ws + WS_HN), (float*)(ws + WS_STASH), (unsigned*)(ws + WS_CTL) + 2048 + 512 * l, l == DEPTH - 1,
                            (const float*)(ws + WS_LAM) + 2 * l, a.in[12] + (size_t)l * 128, a.in[7] + (size_t)l * 8);
        }
        SEAM(p0 + 1);
        if (IN(p0 + 2)) {
            pg8::Gemm g{(const bf16_t*)(ws + WS_HN), (const bf16_t*)(ws + WS_WOUT) + (size_t)l * DM * DM, MROWS, DM, DM};
            pg8::StaticOrder S; S.init(MROWS, DM, (int)gridDim.x, (int)blockIdx.x);
            pg8::EpiStore<false> E{(bf16_t*)(ws + WS_PROJ), DM, nullptr};
            pg8::gemm_phase<pg8::EpiStore<false>, pg8::StaticOrder, true, true>(lds, g, S, E);
        }
        SEAM(p0 + 2);
        if (IN(p0 + 3)) norm_phase(a, l);
        SEAM(p0 + 3);
    }
#undef IN
#undef SEAM
}

extern "C" void kernel_launch(void* const* d_in, const int* in_sizes, int n_in, void* d_out, int out_size, void* d_ws, size_t ws_size, hipStream_t stream) {
    static int grid = 0;
    if (grid == 0) {
        if (n_in != 13 || ws_size < WS_END) { fprintf(stderr, "kernel_launch: need 13 inputs and >= %zu bytes of workspace; got %d, %zu\n", (size_t)WS_END, n_in, ws_size); grid = -1; return; }
        int dev = 0, cus = 0, per_cu = 0;
        if (hipGetDevice(&dev) != hipSuccess || hipDeviceGetAttribute(&cus, hipDeviceAttributeMultiprocessorCount, dev) != hipSuccess) { grid = -1; return; }
        if (hipFuncSetAttribute((const void*)fwd_kernel, hipFuncAttributeMaxDynamicSharedMemorySize, LDS_BYTES) != hipSuccess) { fprintf(stderr, "kernel_launch: hipFuncSetAttribute failed\n"); grid = -1; return; }
        if (hipOccupancyMaxActiveBlocksPerMultiprocessor(&per_cu, (const void*)fwd_kernel, NWAVES * 64, LDS_BYTES) != hipSuccess || per_cu < 1) { fprintf(stderr, "kernel_launch: occupancy query says %d\n", per_cu); per_cu = 1; }
        (void)hipGetLastError();
        grid = cus * 1;
    }
    if (grid < 0) return;
    (void)hipMemsetAsync((char*)d_ws + WS_CTL, 0, CTL_BYTES, stream);
    Args a{};
    for (int i = 0; i < 13; ++i) a.in[i] = (const float*)d_in[i];
    a.out = (float*)d_out; a.ws = (unsigned char*)d_ws; a.ph_lo = 0; a.ph_hi = N_PHASES;
    void* args[] = {&a};
    hipError_t e = hipLaunchCooperativeKernel((const void*)fwd_kernel, dim3(grid), dim3(NWAVES * 64), args, LDS_BYTES, stream);
    if (e != hipSuccess) fprintf(stderr, "cooperative launch failed: %s (grid %d)\n", hipGetErrorString(e), grid);
}
```

```cpp
#include <hip/hip_runtime.h>
#include <hip/hip_cooperative_groups.h>
#include <cstdio>
#include <cstdint>
namespace cg = cooperative_groups;

constexpr int DM = 1024, NIN = 3328, NB = 16, DEPTH = 4;
constexpr int LP = 4112, LS = 2064, SP = 4096, SS = 2048;
constexpr int ROWS_P = NB * LP, ROWS_S = NB * LS, MROWS = ROWS_P + ROWS_S;
constexpr float EPS = 1e-6f;
constexpr int C_AQ = 0, C_AK = 512, C_AV = 640, C_AG = 768, C_BQ = 1280, C_BK = 1792, C_BV = 2304, C_BG = 2816;

constexpr size_t MiB = 1u << 20;
constexpr size_t WS_CTL = 0, CTL_BYTES = 65536;
constexpr size_t WS_LAM = 1 * MiB;
constexpr size_t WS_ROPE = 2 * MiB;
constexpr size_t WS_WIN = 4 * MiB;
constexpr size_t WS_WOUT = 30 * MiB;
constexpr size_t WS_METAH = 38 * MiB;
constexpr size_t WS_STASH = 40 * MiB;
constexpr size_t WS_HN = 72 * MiB;
constexpr size_t WS_PROJ = 266 * MiB;
constexpr size_t WS_END = 894 * MiB;

#define LAS __attribute__((address_space(3)))
typedef unsigned short bf16_t;
typedef short bf16x8 __attribute__((ext_vector_type(8)));
typedef short s16x4 __attribute__((ext_vector_type(4)));
typedef float f32x2 __attribute__((ext_vector_type(2)));
typedef float f32x4 __attribute__((ext_vector_type(4)));
typedef float f32x16 __attribute__((ext_vector_type(16)));
typedef unsigned u32x2 __attribute__((ext_vector_type(2)));
typedef unsigned u32x4 __attribute__((ext_vector_type(4)));

__device__ __forceinline__ unsigned cvtpk(float lo, float hi) {
    typedef __bf16 b2 __attribute__((ext_vector_type(2)));
    f32x2 v = {lo, hi}; b2 b = __builtin_convertvector(v, b2); return __builtin_bit_cast(unsigned, b);
}
__device__ __forceinline__ float bf_lo(unsigned u) { return __uint_as_float(u << 16); }
__device__ __forceinline__ float bf_hi(unsigned u) { return __uint_as_float(u & 0xffff0000u); }
__device__ __forceinline__ float wave_sum(float v, int lane) {
#pragma unroll
    for (int o = 1; o < 64; o <<= 1) v += __int_as_float(__builtin_amdgcn_ds_bpermute((lane ^ o) << 2, __float_as_int(v)));
    return v;
}
__device__ __forceinline__ void row_decode(int row, int& g, int& b, int& pos) {
    if (row < ROWS_P) { g = 0; b = row / LP; pos = row - b * LP; }
    else { const int r = row - ROWS_P; g = 1; b = r / LS; pos = r - b * LS; }
}

namespace pg8 {
#define PG8_LAS __attribute__((address_space(3)))
constexpr int BM = 256, BK = 64, HALF = 128, HTB = HALF * BK * 2  , STAGE_BYTES = 8 * HTB, NXCD = 8, WGM = 8;

__host__ __device__ __forceinline__ int lds_byte(int r, int c) { const int st = (r >> 4) * 2 + (c >> 5), rr = r & 15, cc = c & 31, ob = rr * 64 + cc * 2; return st * 1024 + (ob ^ (((ob >> 9) & 1) << 5)); }
__host__ __device__ __forceinline__ void stage_rc(int b, int& R, int& C) { const int st = b / 1024, sb = b % 1024, swz = sb ^ (((sb >> 9) & 1) << 5); R = (st >> 1) * 16 + swz / 64; C = (st & 1) * 32 + (swz % 64) / 2; }
__host__ __device__ __forceinline__ int perm32(int rho) { const int n = rho >> 4, i = rho & 15; return 8 * (i >> 2) + 4 * n + (i & 3); }

struct Unit { int pm, pn; };
struct Gemm { const bf16_t* A; const bf16_t* Bt; int M, N, K; };

struct StaticOrder {
    int nM, nN, nwg, G, c;
    __host__ __device__ void init(int M, int N, int G_, int c_) { nM = M / BM; nN = N / BM; nwg = nM * nN; G = G_; c = c_; }
    __host__ __device__ bool next(int i, Unit& u) const {
        const long L = (long)i * G + c; if (L >= nwg) return false;
        int wgid = (int)L; { const int q = nwg / NXCD, r = nwg % NXCD, xcd = wgid % NXCD, off = wgid / NXCD; wgid = (xcd < r ? xcd * (q + 1) : r * (q + 1) + (xcd - r) * q) + off; }
        const int nig = WGM * nN, gid = wgid / nig, fm = gid * WGM, gsz = (nM - fm) < WGM ? (nM - fm) : WGM;
        u.pm = fm + ((wgid % nig) % gsz); u.pn = (wgid % nig) / gsz; return true;
    }
    __device__ __forceinline__ void a_ready(const Unit&) const {}
    __device__ __forceinline__ void done(const Unit&) const {}
};

template <bool ROPE> struct EpiStore {
    static constexpr bool PERM = true, AFTER_DRAIN = false;
    bf16_t* O; int ldc; const f32x2* rope;
    __device__ __forceinline__ void operator()(const f32x4 (&acc)[2][2][4][2], const Unit& u, int wr, int wc, int fr, int fq) const {
        const int row0 = u.pm * BM + wr * 64 + fr; const int col0 = u.pn * BM + wc * 32 + 8 * fq;
#pragma unroll
        for (int ai = 0; ai < 2; ++ai)
#pragma unroll
            for (int m = 0; m < 4; ++m) {
                const int row = row0 + ai * HALF + m * 16;
                bf16_t* rowp = O + (size_t)row * ldc + col0;
                int pos = 0;
                if (ROPE) { int g, b; row_decode(row, g, b, pos); }
#pragma unroll
                for (int bj = 0; bj < 2; ++bj) {
                    f32x4 v0 = acc[ai][bj][m][0], v1 = acc[ai][bj][m][1];
                    if (ROPE) {
                        const int half = 2 * u.pn + bj;
                        const bool dorope = (half < 5) || (half >= 10 && half < 18);
                        if (dorope) {
                            const int i0 = ((col0 + bj * HALF) & 63) >> 1;
                            const f32x4* rp = (const f32x4*)(rope + (size_t)pos * 32 + i0);
                            const f32x4 cs0 = rp[0], cs1 = rp[1];
                            f32x4 w0, w1;
                            w0[0] = (v0[0] * cs0[0] - v0[1] * cs0[1]); w0[1] = (v0[1] * cs0[0] + v0[0] * cs0[1]);
                            w0[2] = (v0[2] * cs0[2] - v0[3] * cs0[3]); w0[3] = (v0[3] * cs0[2] + v0[2] * cs0[3]);
                            w1[0] = (v1[0] * cs1[0] - v1[1] * cs1[1]); w1[1] = (v1[1] * cs1[0] + v1[0] * cs1[1]);
                            w1[2] = (v1[2] * cs1[2] - v1[3] * cs1[3]); w1[3] = (v1[3] * cs1[2] + v1[2] * cs1[3]);
                            v0 = w0; v1 = w1;
                        }
                    }
                    u32x4 w; w.x = cvtpk(v0[0], v0[1]); w.y = cvtpk(v0[2], v0[3]); w.z = cvtpk(v1[0], v1[1]); w.w = cvtpk(v1[2], v1[3]);
                    *(u32x4*)(rowp + bj * HALF) = w;
                }
            }
    }
};

template <class Epi, class Sched, bool ALIGN_EPI = false, bool SP2 = false>
__device__ __forceinline__ void gemm_phase(PG8_LAS unsigned char* lds, const Gemm g, const Sched& S, const Epi& E) {
    int tid_ = threadIdx.x; asm volatile("" : "+v"(tid_));
    const int tid = tid_, wid = __builtin_amdgcn_readfirstlane(tid >> 6), lane = tid & 63, wr = wid >> 2, wc = wid & 3, fr = lane & 15, fq = lane >> 4;
    const int K = g.K, nt = K / BK;
    unsigned voffA[2], voffB[2];
#pragma unroll
    for (int i = 0; i < 2; ++i) { int R, C; stage_rc(tid * 16 + i * 8192, R, C); const int Rb = Epi::PERM ? ((R & ~31) + perm32(R & 31)) : R;
        voffA[i] = (unsigned)(R * K + C) * 2u; voffB[i] = (unsigned)(Rb * K + C) * 2u; }
    const size_t kstep = (size_t)(BK * 2);
    const size_t hstep = (size_t)HALF * K * 2;
    const size_t tstep = 2 * hstep;
    const unsigned ldsw = (unsigned)wid * 1024u;
    const int aoff = lds_byte(wr * 64 + fr, fq * 8), boff = lds_byte(wc * 32 + fr, fq * 8);
#define PG8_SA(b, h) (((b) * 2 + (h)) * HTB)
#define PG8_SB(b, h) ((4 + (b) * 2 + (h)) * HTB)
#define PG8_STAGE(bufoff, gbase, voff) do { _Pragma("unroll") for (int _i = 0; _i < 2; ++_i) \
        __builtin_amdgcn_global_load_lds((const unsigned*)((const char*)(gbase) + (voff)[_i]), (PG8_LAS unsigned*)(lds + (bufoff) + ldsw + _i * 8192), 16, 0, 0); } while (0)
#define PG8_LDA(dst, b, h) do { _Pragma("unroll") for (int m = 0; m < 4; ++m) _Pragma("unroll") for (int k = 0; k < 2; ++k) dst[m][k] = *(const PG8_LAS bf16x8*)(lds + PG8_SA(b, h) + aoff + m * 2048 + k * 1024); } while (0)
#define PG8_LDB(dst, b, h) do { _Pragma("unroll") for (int n = 0; n < 2; ++n) _Pragma("unroll") for (int k = 0; k < 2; ++k) dst[n][k] = *(const PG8_LAS bf16x8*)(lds + PG8_SB(b, h) + boff + n * 2048 + k * 1024); } while (0)
#define PG8_MMA(ai, bj, At, Bt) do { __builtin_amdgcn_s_setprio(1); _Pragma("unroll") for (int m = 0; m < 4; ++m) _Pragma("unroll") for (int n = 0; n < 2; ++n) _Pragma("unroll") for (int k = 0; k < 2; ++k) \
        acc[ai][bj][m][n] = __builtin_amdgcn_mfma_f32_16x16x32_bf16(Bt[n][k], At[m][k], acc[ai][bj][m][n], 0, 0, 0); __builtin_amdgcn_s_setprio(0); } while (0)
#define PG8_WAIT_V(n) asm volatile("s_waitcnt vmcnt(" #n ")" ::: "memory")
#define PG8_WAIT_L(n) asm volatile("s_waitcnt lgkmcnt(" #n ")" ::: "memory")
#define PG8_BAR __builtin_amdgcn_s_barrier()
#define PG8_SCHED __builtin_amdgcn_sched_barrier(0)
    Unit cur, nxt; int ui = 0;
    (void)S.next(0, cur);
    f32x4 acc[2][2][4][2];
#pragma unroll
    for (int a = 0; a < 2; ++a)
#pragma unroll
        for (int b = 0; b < 2; ++b)
#pragma unroll
            for (int m = 0; m < 4; ++m)
#pragma unroll
                for (int n = 0; n < 2; ++n) acc[a][b][m][n] = (f32x4){0.f, 0.f, 0.f, 0.f};
    bf16x8 At[4][2], B0[2][2], B1[2][2];
    const char* cA = (const char*)g.A + (size_t)cur.pm * tstep; const char* cB = (const char*)g.Bt + (size_t)cur.pn * tstep;
    S.a_ready(cur);
    if constexpr (SP2) {
        PG8_STAGE(PG8_SB(0, 0), cB, voffB); PG8_STAGE(PG8_SB(0, 1), cB + hstep, voffB); PG8_STAGE(PG8_SA(0, 0), cA, voffA); PG8_STAGE(PG8_SA(0, 1), cA + hstep, voffA);
        if (wr == 1) PG8_BAR;
        PG8_WAIT_V(2); PG8_BAR;
        PG8_STAGE(PG8_SB(1, 0), cB + kstep, voffB); PG8_STAGE(PG8_SA(1, 0), cA + kstep, voffA); PG8_STAGE(PG8_SB(1, 1), cB + hstep + kstep, voffB);
        PG8_WAIT_V(6); PG8_BAR;
    } else {
        PG8_STAGE(PG8_SB(0, 0), cB, voffB); PG8_STAGE(PG8_SA(0, 0), cA, voffA); PG8_STAGE(PG8_SB(0, 1), cB + hstep, voffB); PG8_STAGE(PG8_SA(0, 1), cA + hstep, voffA);
        if (wr == 1) PG8_BAR;
        PG8_WAIT_V(4); PG8_BAR;
        PG8_STAGE(PG8_SB(1, 0), cB + kstep, voffB); PG8_STAGE(PG8_SA(1, 0), cA + kstep, voffA); PG8_STAGE(PG8_SB(1, 1), cB + hstep + kstep, voffB);
        PG8_WAIT_V(6); PG8_BAR;
    }
    for (;;) {
        const bool has_next = S.next(ui + 1, nxt);
        const char* nA = has_next ? (const char*)g.A + (size_t)nxt.pm * tstep : cA; const char* nB = has_next ? (const char*)g.Bt + (size_t)nxt.pn * tstep : cB;
        for (int t = 0; t < nt; t += 2) {
            const bool last = (t == nt - 2);
            const char* a1 = cA + (size_t)(t + 1) * kstep;
            const char* a2 = last ? nA : cA + (size_t)(t + 2) * kstep; const char* b2 = last ? nB : cB + (size_t)(t + 2) * kstep;
            const char* a3 = a2 + kstep; const char* b3 = b2 + kstep;
            if (last && has_next) S.a_ready(nxt);
            if constexpr (SP2) {
            PG8_LDB(B0, 0, 0); PG8_LDB(B1, 0, 1); PG8_SCHED; PG8_LDA(At, 0, 0); PG8_STAGE(PG8_SA(1, 1), a1 + hstep, voffA);
            PG8_WAIT_V(8); PG8_WAIT_L(0); PG8_BAR; PG8_MMA(0, 0, At, B0); PG8_MMA(0, 1, At, B1); PG8_BAR; PG8_SCHED;
            PG8_LDA(At, 0, 1); PG8_STAGE(PG8_SB(0, 0), b2, voffB); PG8_STAGE(PG8_SB(0, 1), b2 + hstep, voffB); PG8_STAGE(PG8_SA(0, 0), a2, voffA);
            PG8_WAIT_V(8); PG8_WAIT_L(0); PG8_BAR; PG8_MMA(1, 0, At, B0); PG8_MMA(1, 1, At, B1); PG8_BAR; PG8_SCHED;
            PG8_LDB(B0, 1, 0); PG8_LDB(B1, 1, 1); PG8_SCHED; PG8_LDA(At, 1, 0); PG8_STAGE(PG8_SA(0, 1), a2 + hstep, voffA);
            PG8_WAIT_V(8); PG8_WAIT_L(0); PG8_BAR; PG8_MMA(0, 0, At, B0); PG8_MMA(0, 1, At, B1); PG8_BAR; PG8_SCHED;
            PG8_LDA(At, 1, 1); PG8_STAGE(PG8_SB(1, 0), b3, voffB); PG8_STAGE(PG8_SB(1, 1), b3 + hstep, voffB); PG8_STAGE(PG8_SA(1, 0), a3, voffA);
            PG8_WAIT_V(8); PG8_WAIT_L(0); PG8_BAR; PG8_MMA(1, 0, At, B0); PG8_MMA(1, 1, At, B1); PG8_BAR; PG8_SCHED;
            } else {
            PG8_LDB(B0, 0, 0); PG8_SCHED; PG8_LDA(At, 0, 0); PG8_STAGE(PG8_SA(1, 1), a1 + hstep, voffA);
            PG8_WAIT_L(8); PG8_BAR; PG8_WAIT_L(0); PG8_MMA(0, 0, At, B0); PG8_BAR; PG8_SCHED;
            PG8_LDB(B1, 0, 1); PG8_STAGE(PG8_SB(0, 0), b2, voffB);
            PG8_BAR; PG8_WAIT_L(0); PG8_MMA(0, 1, At, B1); PG8_BAR;
            PG8_LDA(At, 0, 1); PG8_STAGE(PG8_SA(0, 0), a2, voffA);
            PG8_BAR; PG8_WAIT_L(0); PG8_MMA(1, 0, At, B0); PG8_BAR; PG8_SCHED;
            PG8_STAGE(PG8_SB(0, 1), b2 + hstep, voffB);
            PG8_WAIT_V(6); PG8_BAR; PG8_MMA(1, 1, At, B1); PG8_BAR;
            PG8_LDB(B0, 1, 0); PG8_SCHED; PG8_LDA(At, 1, 0); PG8_STAGE(PG8_SA(0, 1), a2 + hstep, voffA);
            PG8_WAIT_L(8); PG8_BAR; PG8_WAIT_L(0); PG8_MMA(0, 0, At, B0); PG8_BAR; PG8_SCHED;
            PG8_LDB(B1, 1, 1); PG8_STAGE(PG8_SB(1, 0), b3, voffB);
            PG8_BAR; PG8_WAIT_L(0); PG8_MMA(0, 1, At, B1); PG8_BAR;
            PG8_LDA(At, 1, 1); PG8_STAGE(PG8_SA(1, 0), a3, voffA);
            PG8_BAR; PG8_WAIT_L(0); PG8_MMA(1, 0, At, B0); PG8_BAR; PG8_SCHED;
            PG8_STAGE(PG8_SB(1, 1), b3 + hstep, voffB);
            PG8_WAIT_V(6); PG8_BAR; PG8_MMA(1, 1, At, B1); PG8_BAR;
            }
        }
        if constexpr (ALIGN_EPI) { if (wr == 0) PG8_BAR; }
        if constexpr (!Epi::AFTER_DRAIN) { E(acc, cur, wr, wc, fr, fq); S.done(cur); }
        if (!has_next) break;
#pragma unroll
        for (int a = 0; a < 2; ++a)
#pragma unroll
            for (int b = 0; b < 2; ++b)
#pragma unroll
                for (int m = 0; m < 4; ++m)
#pragma unroll
                    for (int n = 0; n < 2; ++n) acc[a][b][m][n] = (f32x4){0.f, 0.f, 0.f, 0.f};
        cur = nxt; cA = nA; cB = nB; ++ui;
        if constexpr (ALIGN_EPI) { if (wr == 1) PG8_BAR; }
    }
    PG8_WAIT_V(0);
    if constexpr (!ALIGN_EPI) { if (wr == 0) PG8_BAR; }
    PG8_BAR;
    if constexpr (Epi::AFTER_DRAIN) { E.fused(acc, cur, wr, wc, fr, fq, lds, wid, lane); S.done(cur); }
#undef PG8_SA
#undef PG8_SB
#undef PG8_STAGE
#undef PG8_LDA
#undef PG8_LDB
#undef PG8_MMA
#undef PG8_WAIT_V
#undef PG8_WAIT_L
#undef PG8_BAR
#undef PG8_SCHED
}
}

namespace att {
typedef short v4i16_t __attribute__((ext_vector_type(4)));
typedef LAS const unsigned char* lcp;
constexpr float NEG = -1.0e30f;
constexpr float LOG2E = 1.4426950408889634f;
constexpr int KP = 144, VP128 = 320, VP64 = 192;
constexpr int KBUF = 64 * KP, VBUF = 64 * VP128;
constexpr int SW_K = 0, SW_V = 24576;
constexpr int OFF_K0 = 0, OFF_K1 = KBUF, OFF_V0 = 2 * KBUF, OFF_V1 = 2 * KBUF + VBUF, OFF_UNIT = 131072;
enum { K_NONE = 0, K_DENSE = 1, K_META = 2, K_BAND = 3, K_METAQ = 4 };

__device__ __forceinline__ int crow(int i, int h) { return (i & 3) + 8 * (i >> 2) + 4 * h; }
__device__ __forceinline__ float swapmax(float v) { auto rr = __builtin_amdgcn_permlane32_swap(__float_as_uint(v), __float_as_uint(v), false, false); return fmaxf(__uint_as_float(rr[0]), __uint_as_float(rr[1])); }
__device__ __forceinline__ float swapsum(float v) { auto rr = __builtin_amdgcn_permlane32_swap(__float_as_uint(v), __float_as_uint(v), false, false); return __uint_as_float(rr[0]) + __uint_as_float(rr[1]); }
__device__ __forceinline__ s16x4 vtr(lcp p) { return __builtin_bit_cast(s16x4, __builtin_amdgcn_ds_read_tr16_b64_v4i16((LAS v4i16_t*)p)); }
__device__ __forceinline__ float max3f(float a, float b, float c) { float r; asm("v_max3_f32 %0, %1, %2, %3" : "=v"(r) : "v"(a), "v"(b), "v"(c)); return r; }
__device__ __forceinline__ float ex2(float x) { return __builtin_amdgcn_exp2f(x); }
__device__ __forceinline__ float silu(float x) { return x * __builtin_amdgcn_rcpf(1.0f + ex2(-x * LOG2E)); }

template <int KIND> __device__ __forceinline__ bool kvalid(int kr, int lim, int qi) {
    if (KIND == K_DENSE) return kr < lim;
    if (KIND == K_META) return kr < 16;
    if (KIND == K_BAND) { const int u = kr - 16; const int d = u - qi; return (unsigned)u < (unsigned)lim && d <= 128 && d >= -128; }
    if (KIND == K_METAQ) { const int u = kr - 16; return kr < 16 || (u < 128 && u <= 112 + qi); }
    return true;
}

template <int DV, int KIND>
__device__ __forceinline__ void tile_compute(f32x16 (&o)[DV / 32], float& m, float& l, const bf16x8 (&qf)[4], lcp kb, lcp vb, int r0, int h, int lim, int qi) {
    constexpr int VP = (DV == 128) ? VP128 : VP64;
    f32x16 s0, s1;
#pragma unroll
    for (int i = 0; i < 16; ++i) { s0[i] = 0.f; s1[i] = 0.f; }
#pragma unroll
    for (int ks = 0; ks < 4; ++ks) {
        const bf16x8 k0 = *(LAS const bf16x8*)(kb + ks * 32);
        const bf16x8 k1 = *(LAS const bf16x8*)(kb + 32 * KP + ks * 32);
        s0 = __builtin_amdgcn_mfma_f32_32x32x16_bf16(k0, qf[ks], s0, 0, 0, 0);
        s1 = __builtin_amdgcn_mfma_f32_32x32x16_bf16(k1, qf[ks], s1, 0, 0, 0);
        if (ks == 1) __builtin_amdgcn_sched_barrier(0);
    }
    if (KIND != K_NONE) {
        int hb = 4 * h + r0; asm volatile("" : "+v"(hb));
#pragma unroll
        for (int i = 0; i < 16; ++i) {
            const int kr = hb + (i & 3) + 8 * (i >> 2);
            s0[i] = kvalid<KIND>(kr, lim, qi) ? s0[i] : NEG;
            s1[i] = kvalid<KIND>(kr + 32, lim, qi) ? s1[i] : NEG;
        }
    }
    float mx = fmaxf(s0[0], s1[0]);
#pragma unroll
    for (int i = 1; i < 16; ++i) mx = fmaxf(mx, fmaxf(s0[i], s1[i]));
    mx = swapmax(mx);
    const float mn = fmaxf(m, mx);
    const float alpha = ex2(m - mn);
    m = mn;
    float rs = 0.f;
#pragma unroll
    for (int i = 0; i < 16; ++i) { s0[i] = ex2(s0[i] - mn); s1[i] = ex2(s1[i] - mn); rs += s0[i] + s1[i]; }
    l = l * alpha + rs;
#pragma unroll
    for (int c = 0; c < DV / 32; ++c)
#pragma unroll
        for (int i = 0; i < 16; ++i) o[c][i] *= alpha;
    bf16x8 pf[4];
    {
        u32x4 w;
        w.x = cvtpk(s0[0], s0[1]); w.y = cvtpk(s0[2], s0[3]); w.z = cvtpk(s0[4], s0[5]); w.w = cvtpk(s0[6], s0[7]); pf[0] = __builtin_bit_cast(bf16x8, w);
        w.x = cvtpk(s0[8], s0[9]); w.y = cvtpk(s0[10], s0[11]); w.z = cvtpk(s0[12], s0[13]); w.w = cvtpk(s0[14], s0[15]); pf[1] = __builtin_bit_cast(bf16x8, w);
        w.x = cvtpk(s1[0], s1[1]); w.y = cvtpk(s1[2], s1[3]); w.z = cvtpk(s1[4], s1[5]); w.w = cvtpk(s1[6], s1[7]); pf[2] = __builtin_bit_cast(bf16x8, w);
        w.x = cvtpk(s1[8], s1[9]); w.y = cvtpk(s1[10], s1[11]); w.z = cvtpk(s1[12], s1[13]); w.w = cvtpk(s1[14], s1[15]); pf[3] = __builtin_bit_cast(bf16x8, w);
    }
    constexpr int NC = DV / 32;
#pragma unroll
    for (int kk = 0; kk < 4; ++kk) {
        s16x4 alo[NC], ahi[NC];
#pragma unroll
        for (int c = 0; c < NC; ++c) { alo[c] = vtr(vb + (16 * kk) * VP + c * 64); ahi[c] = vtr(vb + (16 * kk + 8) * VP + c * 64); }
#pragma unroll
        for (int c = 0; c < NC; ++c) {
            const s16x4 lo = alo[c], hi = ahi[c];
            const bf16x8 a = {lo[0], lo[1], lo[2], lo[3], hi[0], hi[1], hi[2], hi[3]};
            o[c] = __builtin_amdgcn_mfma_f32_32x32x16_bf16(a, pf[kk], o[c], 0, 0, 0);
        }
        __builtin_amdgcn_sched_barrier(0);
    }
}

__device__ __forceinline__ bf16x8 pack8(const f32x16& s, int b) {
    u32x4 w; w.x = cvtpk(s[b], s[b + 1]); w.y = cvtpk(s[b + 2], s[b + 3]); w.z = cvtpk(s[b + 4], s[b + 5]); w.w = cvtpk(s[b + 6], s[b + 7]); return __builtin_bit_cast(bf16x8, w);
}
__device__ __forceinline__ void exp_pv_sw(f32x16 (&o)[4], float m, float& l, f32x16& s0, f32x16& s1, lcp vl, int vB0, int vB1, int q4) {
    const lcp vb0[4] = {vl + vB0 + ((0 ^ q4) << 6), vl + vB0 + ((1 ^ q4) << 6), vl + vB0 + ((2 ^ q4) << 6), vl + vB0 + ((3 ^ q4) << 6)};
    const lcp vb1[4] = {vl + vB1 + ((0 ^ q4) << 6), vl + vB1 + ((1 ^ q4) << 6), vl + vB1 + ((2 ^ q4) << 6), vl + vB1 + ((3 ^ q4) << 6)};
    s16x4 alo[2][4], ahi[2][4];
#define VLOAD(kk, b) do { _Pragma("unroll") for (int c = 0; c < 4; ++c) { alo[b][c] = vtr(vb0[c] + 4096 * (kk)); ahi[b][c] = vtr(vb1[c] + 4096 * (kk)); } } while (0)
#define PVMMA(b, P) do { _Pragma("unroll") for (int c = 0; c < 4; ++c) { const s16x4 lo = alo[b][c], hi = ahi[b][c]; const bf16x8 a = {lo[0], lo[1], lo[2], lo[3], hi[0], hi[1], hi[2], hi[3]}; \
            o[c] = __builtin_amdgcn_mfma_f32_32x32x16_bf16(a, (P), o[c], 0, 0, 0); } } while (0)
#define EXP8(S, b0) do { _Pragma("unroll") for (int i = (b0); i < (b0) + 8; ++i) { S[i] = ex2(S[i]); rs += S[i]; } } while (0)
    float rs = 0.f;
    VLOAD(0, 0);
    EXP8(s0, 0); const bf16x8 p0 = pack8(s0, 0);
    __builtin_amdgcn_sched_barrier(0);
    VLOAD(1, 1); PVMMA(0, p0);
    EXP8(s0, 8); const bf16x8 p1 = pack8(s0, 8);
    __builtin_amdgcn_sched_barrier(0);
    VLOAD(2, 0); PVMMA(1, p1);
    EXP8(s1, 0); const bf16x8 p2 = pack8(s1, 0);
    __builtin_amdgcn_sched_barrier(0);
    VLOAD(3, 1); PVMMA(0, p2);
    EXP8(s1, 8); const bf16x8 p3 = pack8(s1, 8);
    __builtin_amdgcn_sched_barrier(0);
    PVMMA(1, p3);
    l += rs;
    __builtin_amdgcn_sched_barrier(0);
#undef VLOAD
#undef PVMMA
#undef EXP8
}
__device__ __forceinline__ void tile_sw(f32x16 (&o)[4], float& m, float& l, f32x16& negm, const bf16x8 (&qf)[4], lcp kb, int kx, lcp vl, int vB0, int vB1, int q4, int r0, int h, int lim, bool masked, bool first) {
    f32x16 s0, s1;
    bf16x8 kf[4][2];
#pragma unroll
    for (int ks = 0; ks < 4; ++ks) { kf[ks][0] = *(LAS const bf16x8*)(kb + (kx ^ (ks << 5))); kf[ks][1] = *(LAS const bf16x8*)(kb + (kx ^ (ks << 5)) + 4096); }
    __builtin_amdgcn_sched_barrier(0);
#pragma unroll
    for (int ks = 0; ks < 4; ++ks) {
        if (ks == 0) { s0 = __builtin_amdgcn_mfma_f32_32x32x16_bf16(kf[0][0], qf[0], negm, 0, 0, 0); s1 = __builtin_amdgcn_mfma_f32_32x32x16_bf16(kf[0][1], qf[0], negm, 0, 0, 0); }
        else { s0 = __builtin_amdgcn_mfma_f32_32x32x16_bf16(kf[ks][0], qf[ks], s0, 0, 0, 0); s1 = __builtin_amdgcn_mfma_f32_32x32x16_bf16(kf[ks][1], qf[ks], s1, 0, 0, 0); }
    }
    if (masked) {
        int hb = 4 * h + r0; asm volatile("" : "+v"(hb));
#pragma unroll
        for (int i = 0; i < 16; ++i) {
            const int kr = hb + (i & 3) + 8 * (i >> 2);
            s0[i] = kr < lim ? s0[i] : NEG;
            s1[i] = kr + 32 < lim ? s1[i] : NEG;
        }
    }
    asm volatile("s_nop 15" : "+v"(s0), "+v"(s1));
    float mxa = max3f(s0[0], s0[1], s1[0]), mxb = max3f(s0[2], s0[3], s1[1]);
    mxa = max3f(mxa, s1[2], s1[3]);
#pragma unroll
    for (int i = 4; i < 16; i += 4) { mxa = max3f(mxa, s0[i], s0[i + 1]); mxb = max3f(mxb, s0[i + 2], s0[i + 3]); mxa = max3f(mxa, s1[i], s1[i + 1]); mxb = max3f(mxb, s1[i + 2], s1[i + 3]); }
    float mx = max3f(mxa, mxb, mxb);
    mx = swapmax(mx);
    if (first || __builtin_amdgcn_ballot_w64(mx > 8.0f) != 0ull) {
        const float delta = first ? mx : fmaxf(mx, 0.f);
        const float alpha = first ? 1.0f : ex2(-delta);
        m += delta; l *= alpha;
#pragma unroll
        for (int c = 0; c < 4; ++c)
#pragma unroll
            for (int i = 0; i < 16; ++i) asm volatile("v_mul_f32 %0, %1, %0" : "+v"(o[c][i]) : "v"(alpha));
#pragma unroll
        for (int i = 0; i < 16; ++i) { s0[i] -= delta; s1[i] -= delta; negm[i] = -m; }
    }
    exp_pv_sw(o, m, l, s0, s1, vl, vB0, vB1, q4);
}

__device__ __forceinline__ void glds16(const void* gsrc, unsigned lds_dst) {
    unsigned keep;
    asm volatile("s_mov_b32 %0, m0\n\ts_mov_b32 m0, %2\n\ts_nop 0\n\tglobal_load_lds_dwordx4 %1, off\n\ts_mov_b32 m0, %0" : "=&s"(keep) : "v"(gsrc), "s"(lds_dst) : "memory");
}
__device__ __forceinline__ int clampi(int v, int lo, int hi) { return v < lo ? lo : (v > hi ? hi : v); }

__device__ __forceinline__ void diff_unit(LAS unsigned char* lds, const bf16_t* __restrict__ proj, bf16_t* __restrict__ aout, float* __restrict__ stash,
                                          int g, int b, int hh, int qb, const float* __restrict__ lamp, const float* __restrict__ subg) {
    int tid_ = threadIdx.x; asm volatile("" : "+v"(tid_));
    const int tid = tid_, lane = tid & 63, r32 = lane & 31, h = lane >> 5;
    const int w = __builtin_amdgcn_readfirstlane(tid >> 6);
    const int L = g ? LS : LP, brow0 = g ? ROWS_P + b * LS : b * LP, NT = (L + 63) >> 6;
    const bool active = (qb >= 0) || (w == 0);
    const int qrow = (qb >= 0) ? 16 + 256 * qb + 32 * w + r32 : r32;
    const bool rowvalid = (qb >= 0) || (r32 < 16);
    const int kkey = 8 * w + (lane >> 3), kchunk = (lane & 7) ^ ((kkey >> 1) & 7);
    const int vkey0 = 8 * w + (lane >> 4), vkey1 = vkey0 + 4;
    const int vchunk0 = (lane & 15) ^ (((vkey0 & 3) << 2) | ((vkey0 >> 2) & 3)), vchunk1 = (lane & 15) ^ (((vkey1 & 3) << 2) | ((vkey1 >> 2) & 3));
    const bf16_t* kbase = proj + (size_t)brow0 * NIN + C_BK + hh * 128 + kchunk * 8;
    const bf16_t* vbase0 = proj + (size_t)brow0 * NIN + C_BV + hh * 128 + vchunk0 * 8;
    const bf16_t* vbase1 = proj + (size_t)brow0 * NIN + C_BV + hh * 128 + vchunk1 * 8;
    const int fsw = (r32 >> 1) & 7;
    const lcp kb = (lcp)lds + r32 * 128 + ((h ^ (fsw & 1)) * 16);
    const int kx = (fsw >> 1) << 5;
    const int q4 = (lane & 15) >> 2, blk = (lane >> 4) & 1, p4 = lane & 3;
    const int vB0 = (4 * h + q4) * 256 + (((2 * blk + (p4 >> 1)) ^ h) * 16) + 8 * (p4 & 1);
    const int vB1 = (vB0 ^ 32) + 2048;

    f32x16 o[4]; float m = 0.f, l = 0.f; bf16x8 qf[4]; f32x16 negm;
#pragma unroll
    for (int i = 0; i < 16; ++i) negm[i] = 0.f;
#pragma unroll
    for (int c = 0; c < 4; ++c)
#pragma unroll
        for (int i = 0; i < 16; ++i) o[c][i] = 0.f;
    const int total = 2 * NT;
    const unsigned ldsw_k = (unsigned)w * 1024u, ldsw_v = (unsigned)w * 2048u;
    const unsigned lds0 = (unsigned)(size_t)lds;
    const bf16_t* kp = kbase + (size_t)kkey * NIN; const bf16_t* vp0 = vbase0 + (size_t)vkey0 * NIN; const bf16_t* vp1 = vbase1 + (size_t)vkey1 * NIN;
#define DIFF_DMA(tn, kslot, vslot) do { \
        glds16(kp, (unsigned)__builtin_amdgcn_readfirstlane(lds0 + SW_K + (kslot) * 8192 + ldsw_k)); \
        glds16(vp0, (unsigned)__builtin_amdgcn_readfirstlane(lds0 + SW_V + (vslot) * 16384 + ldsw_v)); \
        glds16(vp1, (unsigned)__builtin_amdgcn_readfirstlane(lds0 + SW_V + (vslot) * 16384 + ldsw_v + 1024u)); \
        { const bool wrap_ = ((tn) + 1 == NT);                   \
          const long dk_ = wrap_ ? (long)64 - (long)(NT - 1) * 64 * NIN : (long)64 * NIN, dv_ = wrap_ ? -(long)(NT - 1) * 64 * NIN : (long)64 * NIN; \
          kp += dk_; vp0 += dv_; vp1 += dv_; } } while (0)
    DIFF_DMA(0, 0, 0); DIFF_DMA(1, 1, 1);
    asm volatile("s_waitcnt vmcnt(3)" ::: "memory");
    __builtin_amdgcn_s_barrier(); asm volatile("" ::: "memory");
    int k_cur = 0, k_nn = 2, v_cur = 0, v_nn = 2;
    for (int t = 0; t < total; ++t) {
        const int c = t >= NT ? 1 : 0, tt = t - c * NT;
        if (tt == 0) {
            if (c == 1 && active) {
                const float inv = __builtin_amdgcn_rcpf(swapsum(l));
                int td = tid; asm volatile("" : "+v"(td));
                float* sp = stash + ((size_t)blockIdx.x * 512 + td) * 64;
#pragma unroll
                for (int cc = 0; cc < 4; ++cc)
#pragma unroll
                    for (int g4 = 0; g4 < 4; ++g4) {
                        f32x4 v = {o[cc][4 * g4] * inv, o[cc][4 * g4 + 1] * inv, o[cc][4 * g4 + 2] * inv, o[cc][4 * g4 + 3] * inv};
                        *(f32x4*)(sp + cc * 16 + g4 * 4) = v;
                        o[cc][4 * g4] = 0.f; o[cc][4 * g4 + 1] = 0.f; o[cc][4 * g4 + 2] = 0.f; o[cc][4 * g4 + 3] = 0.f;
                    }
                m = 0.f; l = 0.f;
#pragma unroll
                for (int i = 0; i < 16; ++i) negm[i] = 0.f;
            }
            int qr = qrow; asm volatile("" : "+v"(qr));
            const bf16_t* qp = proj + (size_t)(brow0 + qr) * NIN + C_BQ + hh * 128 + h * 8 + c * 64;
#pragma unroll
            for (int ks = 0; ks < 4; ++ks) qf[ks] = *(const bf16x8*)(qp + ks * 16);
            asm volatile("" : "+v"(qf[0]), "+v"(qf[1]), "+v"(qf[2]), "+v"(qf[3]) :: "memory");
        }
        if (t + 2 < total) DIFF_DMA(t + 2, k_nn, v_nn);
        if (active) {
            const int bo_k = SW_K + k_cur * 8192;
            const lcp vl = (lcp)lds + SW_V + v_cur * 16384;
            tile_sw(o, m, l, negm, qf, kb + bo_k, kx, vl, vB0, vB1, q4, 64 * tt, h, L, tt == NT - 1, tt == 0);
        }
        if (t + 2 < total) asm volatile("s_waitcnt vmcnt(3)" ::: "memory"); else asm volatile("s_waitcnt vmcnt(0)" ::: "memory");
        __builtin_amdgcn_s_barrier(); asm volatile("" ::: "memory");
        k_cur = (k_cur == 2) ? 0 : k_cur + 1; k_nn = (k_nn == 2) ? 0 : k_nn + 1;
        v_cur = (v_cur + 1) & 3; v_nn = (v_nn + 1) & 3;
    }
#undef DIFF_DMA
    if (active) {
        int td = tid, qr = qrow; asm volatile("" : "+v"(td), "+v"(qr));
        const float lam = lamp[0], oml = lamp[1];
        const float inv = __builtin_amdgcn_rcpf(swapsum(l)) * lam;
        const float* sp = stash + ((size_t)blockIdx.x * 512 + td) * 64;
        float ss = 0.f;
#pragma unroll
        for (int cc = 0; cc < 4; ++cc)
#pragma unroll
            for (int g4 = 0; g4 < 4; ++g4) {
                const f32x4 sv = *(const f32x4*)(sp + cc * 16 + g4 * 4);
#pragma unroll
                for (int e = 0; e < 4; ++e) { const float v = sv[e] - o[cc][4 * g4 + e] * inv; o[cc][4 * g4 + e] = v; ss += v * v; }
                if (g4 == 3) __builtin_amdgcn_sched_barrier(0);
            }
        ss = swapsum(ss);
        const float rstd = __builtin_amdgcn_rsqf(ss * (1.0f / 128.0f) + EPS) * oml;
        if (rowvalid) {
            const bf16_t* gp = proj + (size_t)(brow0 + qr) * NIN + C_BG + hh * 128;
            bf16_t* op = aout + (size_t)(brow0 + qr) * DM + 512 + hh * 128;
#pragma unroll
            for (int cc = 0; cc < 4; ++cc)
#pragma unroll
                for (int g4 = 0; g4 < 4; ++g4) {
                    const int d = 32 * cc + 8 * g4 + 4 * h;
                    const u32x2 gt = *(const u32x2*)(gp + d);
                    const f32x4 sg = *(const f32x4*)(subg + d);
                    const float v0 = o[cc][4 * g4 + 0] * rstd * sg[0] * silu(bf_lo(gt.x));
                    const float v1 = o[cc][4 * g4 + 1] * rstd * sg[1] * silu(bf_hi(gt.x));
                    const float v2 = o[cc][4 * g4 + 2] * rstd * sg[2] * silu(bf_lo(gt.y));
                    const float v3 = o[cc][4 * g4 + 3] * rstd * sg[3] * silu(bf_hi(gt.y));
                    u32x2 ov; ov.x = cvtpk(v0, v1); ov.y = cvtpk(v2, v3);
                    *(u32x2*)(op + d) = ov;
                    if (g4 & 1) __builtin_amdgcn_sched_barrier(0);
                }
        }
    }
}

constexpr int WK = 0, WV = 49152;
enum { M_NONE = 0, M_META = 1, M_BAND = 2, M_METAQ = 3 };
__device__ __forceinline__ void wait_vm(int n) {
    switch (n) {
        case 0: asm volatile("s_waitcnt vmcnt(0)" ::: "memory"); break;
        case 2: asm volatile("s_waitcnt vmcnt(2)" ::: "memory"); break;
        case 4: asm volatile("s_waitcnt vmcnt(4)" ::: "memory"); break;
        case 6: asm volatile("s_waitcnt vmcnt(6)" ::: "memory"); break;
        case 8: asm volatile("s_waitcnt vmcnt(8)" ::: "memory"); break;
        default: asm volatile("s_waitcnt vmcnt(10)" ::: "memory"); break;
    }
}
__device__ __forceinline__ void tile_win(f32x16 (&o)[2], float& m, float& l, f32x16& negm, const bf16x8 (&qf)[4], lcp kb, int kx, lcp vl, int vB0, int q1, int r0, int h, int S, int qi, int kind, bool first) {
    f32x16 s0, s1;
    bf16x8 kf[4][2];
#pragma unroll
    for (int ks = 0; ks < 4; ++ks) { kf[ks][0] = *(LAS const bf16x8*)(kb + (kx ^ (ks << 5))); kf[ks][1] = *(LAS const bf16x8*)(kb + (kx ^ (ks << 5)) + 4096); }
    __builtin_amdgcn_sched_barrier(0);
#pragma unroll
    for (int ks = 0; ks < 4; ++ks) {
        if (ks == 0) { s0 = __builtin_amdgcn_mfma_f32_32x32x16_bf16(kf[0][0], qf[0], negm, 0, 0, 0); s1 = __builtin_amdgcn_mfma_f32_32x32x16_bf16(kf[0][1], qf[0], negm, 0, 0, 0); }
        else { s0 = __builtin_amdgcn_mfma_f32_32x32x16_bf16(kf[ks][0], qf[ks], s0, 0, 0, 0); s1 = __builtin_amdgcn_mfma_f32_32x32x16_bf16(kf[ks][1], qf[ks], s1, 0, 0, 0); }
    }
    if (kind != M_NONE) {
        int hb = 4 * h + r0; asm volatile("" : "+v"(hb));
        if (kind == M_META) {
#pragma unroll
            for (int i = 0; i < 16; ++i) { const int kr = hb + (i & 3) + 8 * (i >> 2); s0[i] = kvalid<K_META>(kr, S, qi) ? s0[i] : NEG; s1[i] = kvalid<K_META>(kr + 32, S, qi) ? s1[i] : NEG; }
        } else if (kind == M_BAND) {
#pragma unroll
            for (int i = 0; i < 16; ++i) { const int kr = hb + (i & 3) + 8 * (i >> 2); s0[i] = kvalid<K_BAND>(kr, S, qi) ? s0[i] : NEG; s1[i] = kvalid<K_BAND>(kr + 32, S, qi) ? s1[i] : NEG; }
        } else {
#pragma unroll
            for (int i = 0; i < 16; ++i) { const int kr = hb + (i & 3) + 8 * (i >> 2); s0[i] = kvalid<K_METAQ>(kr, S, qi) ? s0[i] : NEG; s1[i] = kvalid<K_METAQ>(kr + 32, S, qi) ? s1[i] : NEG; }
        }
    }
    asm volatile("s_nop 15" : "+v"(s0), "+v"(s1));
    float mxa = max3f(s0[0], s0[1], s1[0]), mxb = max3f(s0[2], s0[3], s1[1]);
    mxa = max3f(mxa, s1[2], s1[3]);
#pragma unroll
    for (int i = 4; i < 16; i += 4) { mxa = max3f(mxa, s0[i], s0[i + 1]); mxb = max3f(mxb, s0[i + 2], s0[i + 3]); mxa = max3f(mxa, s1[i], s1[i + 1]); mxb = max3f(mxb, s1[i + 2], s1[i + 3]); }
    float mx = max3f(mxa, mxb, mxb);
    mx = swapmax(mx);
    if (first || __builtin_amdgcn_ballot_w64(mx > 8.0f) != 0ull) {
        const float delta = first ? mx : fmaxf(mx, 0.f);
        const float alpha = first ? 1.0f : ex2(-delta);
        m += delta; l *= alpha;
#pragma unroll
        for (int c = 0; c < 2; ++c)
#pragma unroll
            for (int i = 0; i < 16; ++i) asm volatile("v_mul_f32 %0, %1, %0" : "+v"(o[c][i]) : "v"(alpha));
#pragma unroll
        for (int i = 0; i < 16; ++i) { s0[i] -= delta; s1[i] -= delta; negm[i] = -m; }
    }
    const lcp vb0[2] = {vl + vB0 + ((0 ^ q1) << 6), vl + vB0 + ((1 ^ q1) << 6)};
    s16x4 alo[2][2], ahi[2][2];
#define VLOAD(kk, b) do { _Pragma("unroll") for (int c = 0; c < 2; ++c) { alo[b][c] = vtr(vb0[c] + 2048 * (kk)); ahi[b][c] = vtr(vb0[c] + 2048 * (kk) + 1024); } } while (0)
#define PVMMA(b, P) do { _Pragma("unroll") for (int c = 0; c < 2; ++c) { const s16x4 lo = alo[b][c], hi = ahi[b][c]; const bf16x8 a = {lo[0], lo[1], lo[2], lo[3], hi[0], hi[1], hi[2], hi[3]}; \
            o[c] = __builtin_amdgcn_mfma_f32_32x32x16_bf16(a, (P), o[c], 0, 0, 0); } } while (0)
#define EXP8(S_, b0) do { _Pragma("unroll") for (int i = (b0); i < (b0) + 8; ++i) { S_[i] = ex2(S_[i]); rs += S_[i]; } } while (0)
    float rs = 0.f;
    VLOAD(0, 0);
    EXP8(s0, 0); const bf16x8 p0 = pack8(s0, 0);
    __builtin_amdgcn_sched_barrier(0);
    VLOAD(1, 1); PVMMA(0, p0);
    EXP8(s0, 8); const bf16x8 p1 = pack8(s0, 8);
    __builtin_amdgcn_sched_barrier(0);
    VLOAD(2, 0); PVMMA(1, p1);
    EXP8(s1, 0); const bf16x8 p2 = pack8(s1, 0);
    __builtin_amdgcn_sched_barrier(0);
    VLOAD(3, 1); PVMMA(0, p2);
    EXP8(s1, 8); const bf16x8 p3 = pack8(s1, 8);
    __builtin_amdgcn_sched_barrier(0);
    PVMMA(1, p3);
    l += rs;
    __builtin_amdgcn_sched_barrier(0);
#undef VLOAD
#undef PVMMA
#undef EXP8
}
__device__ __forceinline__ void win_unit(LAS unsigned char* lds, const bf16_t* __restrict__ proj, bf16_t* __restrict__ aout,
                                         int g, int b, int kh, int qb, const float* __restrict__ sink) {
    int tid_ = threadIdx.x; asm volatile("" : "+v"(tid_));
    const int tid = tid_, lane = tid & 63, r32 = lane & 31, h = lane >> 5;
    const int w = __builtin_amdgcn_readfirstlane(tid >> 6);
    const int L = g ? LS : LP, S = g ? SS : SP, brow0 = g ? ROWS_P + b * LS : b * LP;
    const bool real = qb >= 0;
    const bool active = real || (w < 2);
    const int ntile = real ? 6 : 3;
    const int hq = real ? 4 * kh + (w & 3) : 4 * kh + 2 * (w & 1) + (r32 >> 4);
    const int qi = real ? 64 * qb + 32 * (w >> 2) + r32 : (r32 & 15);
    const int qrow = real ? 16 + qi : qi;
    const int band0 = 16 + 64 * qb - 128;
    const int kkey = 8 * w + (lane >> 3), kchunk = (lane & 7) ^ ((kkey >> 1) & 7), vchunk = (lane & 7) ^ (((kkey >> 1) & 1) << 2);
    const bf16_t* kbase = proj + (size_t)brow0 * NIN + C_AK + kh * 64 + kchunk * 8;
    const bf16_t* vbase = proj + (size_t)brow0 * NIN + C_AV + kh * 64 + vchunk * 8;
    const int fsw = (r32 >> 1) & 7;
    const lcp kb = (lcp)lds + WK + r32 * 128 + ((h ^ (fsw & 1)) * 16);
    const int kx = (fsw >> 1) << 5;
    const int q4 = (lane & 15) >> 2, blk = (lane >> 4) & 1, p4 = lane & 3;
    const int vB0 = (4 * h + q4) * 128 + (2 * blk + (p4 >> 1)) * 16 + 8 * (p4 & 1);
    const unsigned lds0 = (unsigned)(size_t)lds;

    f32x16 o[2]; float m = 0.f, l = 0.f; bf16x8 qf[4]; f32x16 negm;
#pragma unroll
    for (int i = 0; i < 16; ++i) { o[0][i] = 0.f; o[1][i] = 0.f; negm[i] = 0.f; }
    {
        const bf16_t* qptr = proj + (size_t)(brow0 + qrow) * NIN + C_AQ + hq * 64 + h * 8;
#pragma unroll
        for (int ks = 0; ks < 4; ++ks) qf[ks] = *(const bf16x8*)(qptr + ks * 16);
        asm volatile("" : "+v"(qf[0]), "+v"(qf[1]), "+v"(qf[2]), "+v"(qf[3]) :: "memory");
    }
#define WIN_R0(t) (real ? ((t) == 0 ? 0 : band0 + 64 * ((t) - 1)) : 64 * (t))
    for (int t = 0; t < ntile; ++t) {
        const size_t ro = (size_t)clampi(WIN_R0(t) + kkey, 0, L - 1) * NIN;
        glds16(kbase + ro, (unsigned)__builtin_amdgcn_readfirstlane(lds0 + WK + t * 8192 + w * 1024));
        glds16(vbase + ro, (unsigned)__builtin_amdgcn_readfirstlane(lds0 + WV + t * 8192 + w * 1024));
    }
    for (int t = 0; t < ntile; ++t) {
        wait_vm(2 * (ntile - 1 - t));
        __builtin_amdgcn_s_barrier(); asm volatile("" ::: "memory");
        if (active) {
            const int r0 = WIN_R0(t);
            int kind;
            if (!real) kind = M_METAQ;
            else if (t == 0) kind = M_META;
            else {
                const int u0 = r0 - 16, q0 = 64 * qb;
                kind = (u0 >= 0 && u0 + 63 < S && u0 + 63 - q0 <= 128 && q0 + 63 - u0 <= 128) ? M_NONE : M_BAND;
            }
            tile_win(o, m, l, negm, qf, kb + t * 8192, kx, (lcp)lds + WV + t * 8192, vB0, q4 >> 1, r0, h, S, qi, kind, t == 0);
        }
    }
#undef WIN_R0
    __builtin_amdgcn_s_barrier(); asm volatile("" ::: "memory");
    if (active) {
        int qr = qrow; asm volatile("" : "+v"(qr));
        const float lt = swapsum(l) + ex2(sink[hq] * LOG2E - m);
        const float inv = __builtin_amdgcn_rcpf(lt);
        const bf16_t* gp = proj + (size_t)(brow0 + qr) * NIN + C_AG + hq * 64;
        bf16_t* op = aout + (size_t)(brow0 + qr) * DM + hq * 64;
#pragma unroll
        for (int cc = 0; cc < 2; ++cc)
#pragma unroll
            for (int g4 = 0; g4 < 4; ++g4) {
                const int d = 32 * cc + 8 * g4 + 4 * h;
                const u32x2 gt = *(const u32x2*)(gp + d);
                const float v0 = o[cc][4 * g4 + 0] * inv * silu(bf_lo(gt.x));
                const float v1 = o[cc][4 * g4 + 1] * inv * silu(bf_hi(gt.x));
                const float v2 = o[cc][4 * g4 + 2] * inv * silu(bf_lo(gt.y));
                const float v3 = o[cc][4 * g4 + 3] * inv * silu(bf_hi(gt.y));
                u32x2 ov; ov.x = cvtpk(v0, v1); ov.y = cvtpk(v2, v3);
                *(u32x2*)(op + d) = ov;
            }
    }
}

__device__ __forceinline__ void attn_phase(LAS unsigned char* lds, const bf16_t* proj, bf16_t* aout, float* stash, unsigned* ctr, bool last,
                                           const float* lamp, const float* subg, const float* sink) {
    const int nP = last ? 16 : 17, nS = last ? 8 : 9;
    const int e1 = 8 * nP, e2 = e1 + 8 * nS, e3 = e2 + 256, e4 = e3 + 128, e5 = e4 + (last ? 0 : 8);
    LAS volatile int* su = (LAS volatile int*)(lds + OFF_UNIT);
    const int xcd = (int)(__builtin_amdgcn_s_getreg((3 << 11) | 20) & 7u);
    int kq = 0;
    for (;;) {
        if (threadIdx.x == 0) {
            int u = -1, x = 0;
            while (kq < 8) {
                x = (xcd + kq) & 7;
                int z; asm volatile("v_mov_b32 %0, 0" : "=v"(z));
                const int v = (int)__hip_atomic_fetch_add(ctr + 16 * x + z, 1u, __ATOMIC_RELAXED, __HIP_MEMORY_SCOPE_AGENT);
                if (v < e5) { u = v; break; }
                ++kq;
            }
            su[0] = u; su[1] = x;
        }
        __syncthreads();
        const int u = su[0], x = su[1];
        __syncthreads();
        if (u < 0) break;
        if (u < e2) {
            int g, bh, qb;
            if (u < e1) { const int j = u / nP, r = u - j * nP; g = 0; bh = x + 8 * j; qb = r < 16 ? r : -1; }
            else { const int v = u - e1, j = v / nS, r = v - j * nS; g = 1; bh = x + 8 * j; qb = r < 8 ? r : -1; }
            diff_unit(lds, proj, aout, stash, g, bh >> 2, bh & 3, qb, lamp, subg);
        } else {
            int g, bk, qb;
            if (u < e3) { const int v = u - e2; g = 0; bk = x + 8 * (v >> 6); qb = v & 63; }
            else if (u < e4) { const int v = u - e3; g = 1; bk = x + 8 * (v >> 5); qb = v & 31; }
            else { const int v = u - e4; g = v >> 2; bk = x + 8 * (v & 3); qb = -1; }
            win_unit(lds, proj, aout, g, bk >> 1, bk & 1, qb, sink);
        }
    }
}
}

constexpr int NWAVES = 8;
constexpr int LDS_BYTES = 147456;
constexpr int N_PHASES = 1 + 4 * DEPTH;

__device__ __forceinline__ void grid_bar(unsigned* cnt, unsigned target) {
    asm volatile("s_waitcnt vmcnt(0)" ::: "memory");
    __syncthreads();
    if (threadIdx.x == 0) {
        __builtin_amdgcn_fence(__ATOMIC_RELEASE, "agent");
        asm volatile("s_waitcnt vmcnt(0)" ::: "memory");
        int z; asm volatile("v_mov_b32 %0, 0" : "=v"(z));
        __hip_atomic_fetch_add(cnt + z, 1u, __ATOMIC_RELAXED, __HIP_MEMORY_SCOPE_AGENT);
        while (__hip_atomic_load(cnt, __ATOMIC_RELAXED, __HIP_MEMORY_SCOPE_AGENT) < target) __builtin_amdgcn_s_sleep(2);
        __builtin_amdgcn_fence(__ATOMIC_ACQUIRE, "agent");
        asm volatile("s_waitcnt vmcnt(0)" ::: "memory");
    }
    __syncthreads();
}

struct Args { const float* in[13]; float* out; unsigned char* ws; int ph_lo, ph_hi; };

__device__ __forceinline__ int src_col(int n) {
    const bool r = (n < C_AV) || (n >= C_BQ && n < C_BV);
    if (!r) return n;
    const int w = n & 63;
    return (n & ~63) + (w >> 1) + 32 * (w & 1);
}
__device__ __forceinline__ void transpose_item(const float* __restrict__ W, int N, bf16_t* __restrict__ WT, LAS float* scr, int item, int lane, bool permute) {
    const int nblk = N / 32, kb = item / nblk, nb = item % nblk, k0 = 64 * kb, n0 = 32 * nb;
    const int sc = permute ? src_col(n0 + (lane & 31)) : n0 + (lane & 31);
#pragma unroll 8
    for (int i = 0; i < 32; ++i) { const int kk = 2 * i + (lane >> 5); scr[kk * 33 + (lane & 31)] = W[(size_t)(k0 + kk) * N + sc]; }
    asm volatile("s_waitcnt lgkmcnt(0)" ::: "memory");
    const int c = lane & 7;
#pragma unroll
    for (int j = 0; j < 4; ++j) {
        const int n = (lane >> 3) + 8 * j; const LAS float* s = scr + (8 * c) * 33 + n;
        const int nn = n0 + n; const float sc = (permute && (nn < C_AK || (nn >= C_BQ && nn < C_BK))) ? 0.125f * 1.4426950408889634f : 1.0f;
        u32x4 o; o.x = cvtpk(s[0 * 33] * sc, s[1 * 33] * sc); o.y = cvtpk(s[2 * 33] * sc, s[3 * 33] * sc); o.z = cvtpk(s[4 * 33] * sc, s[5 * 33] * sc); o.w = cvtpk(s[6 * 33] * sc, s[7 * 33] * sc);
        *(u32x4*)(WT + (size_t)nn * 1024 + k0 + 8 * c) = o;
    }
    asm volatile("s_waitcnt lgkmcnt(0)" ::: "memory");
}

__device__ __forceinline__ const float* h0_row(const Args& a, int g, int b, int pos) {
    if (pos < 16) return a.in[2] + (size_t)pos * DM;
    return (g ? a.in[1] : a.in[0]) + ((size_t)b * (g ? SS : SP) + (pos - 16)) * DM;
}

__device__ __forceinline__ void prologue(const Args& a, LAS unsigned char* lds) {
    int tid_ = threadIdx.x; asm volatile("" : "+v"(tid_));
    const int tid = tid_, lane = tid & 63, wave = tid >> 6;
    const int gw = blockIdx.x * NWAVES + wave, NGW = gridDim.x * NWAVES;
    unsigned char* ws = a.ws;
    LAS float* scr = (LAS float*)(lds + wave * 16384);
    constexpr int I_IN = 16 * (NIN / 32), I_OUT = 16 * (DM / 32);
    constexpr int NITEMS = DEPTH * (I_IN + I_OUT);
    for (int it = gw; it < NITEMS; it += NGW) {
        if (it < DEPTH * I_IN) { const int l = it / I_IN, r = it - l * I_IN;
            transpose_item(a.in[3] + (size_t)l * DM * NIN, NIN, (bf16_t*)(ws + WS_WIN) + (size_t)l * NIN * DM, scr, r, lane, true); }
        else { const int q = it - DEPTH * I_IN, l = q / I_OUT, r = q - l * I_OUT;
            transpose_item(a.in[4] + (size_t)l * DM * DM, DM, (bf16_t*)(ws + WS_WOUT) + (size_t)l * DM * DM, scr, r, lane, false); }
    }
    {
        f32x2* rope = (f32x2*)(ws + WS_ROPE);
        for (int e = blockIdx.x * 512 + tid; e < LP * 32; e += gridDim.x * 512) {
            const int pos = e >> 5, i = e & 31;
            const float inv_freq = __builtin_amdgcn_exp2f(-(float)i * (13.287712379549449f / 32.0f));
            const float ang = (float)pos * inv_freq;
            const float rev = ang * 0.15915494309189535f;
            const float fr = rev - floorf(rev);
            f32x2 cs; cs.x = __builtin_amdgcn_cosf(fr); cs.y = __builtin_amdgcn_sinf(fr);
            rope[e] = cs;
        }
    }
    {
        const float* pg = a.in[5];
        bf16_t* hn = (bf16_t*)(ws + WS_HN);
        for (int row0 = gw; row0 < MROWS; row0 += 2 * NGW) {
            f32x4 v[2][4]; bool live[2]; int rows[2];
#pragma unroll
            for (int u = 0; u < 2; ++u) {
                const int row = row0 + u * NGW; live[u] = row < MROWS; rows[u] = live[u] ? row : MROWS - 1;
                int g, b, pos; row_decode(rows[u], g, b, pos);
                const float* x = h0_row(a, g, b, pos);
#pragma unroll
                for (int j = 0; j < 2; ++j) { v[u][2 * j] = *(const f32x4*)(x + 512 * j + lane * 8); v[u][2 * j + 1] = *(const f32x4*)(x + 512 * j + lane * 8 + 4); }
            }
#pragma unroll
            for (int u = 0; u < 2; ++u) {
                if (!live[u]) continue;
                float ss = 0.f;
#pragma unroll
                for (int j = 0; j < 4; ++j) ss += (v[u][j][0] * v[u][j][0] + v[u][j][1] * v[u][j][1]) + (v[u][j][2] * v[u][j][2] + v[u][j][3] * v[u][j][3]);
                const float rstd = __builtin_amdgcn_rsqf(wave_sum(ss, lane) * (1.0f / DM) + EPS);
#pragma unroll
                for (int j = 0; j < 2; ++j) {
                    const f32x4 g0 = *(const f32x4*)(pg + 512 * j + lane * 8), g1 = *(const f32x4*)(pg + 512 * j + lane * 8 + 4);
                    const f32x4 a0 = v[u][2 * j] * rstd * g0, a1 = v[u][2 * j + 1] * rstd * g1;
                    u32x4 o; o.x = cvtpk(a0[0], a0[1]); o.y = cvtpk(a0[2], a0[3]); o.z = cvtpk(a1[0], a1[1]); o.w = cvtpk(a1[2], a1[3]);
                    *(u32x4*)(hn + (size_t)rows[u] * DM + 512 * j + lane * 8) = o;
                }
            }
        }
    }
    {
        u32x4* pad = (u32x4*)(ws + WS_PROJ + (size_t)MROWS * NIN * 2);
        const u32x4 z = {0u, 0u, 0u, 0u};
        for (int e = blockIdx.x * 512 + tid; e < (64 * NIN * 2) / 16; e += gridDim.x * 512) pad[e] = z;
    }
    if (blockIdx.x == 0 && wave == 0) {
        float* lamv = (float*)(ws + WS_LAM);
        for (int l = 0; l < DEPTH; ++l) {
            const float s1 = wave_sum(a.in[8][l * 64 + lane] * a.in[9][l * 64 + lane], lane);
            const float s2 = wave_sum(a.in[10][l * 64 + lane] * a.in[11][l * 64 + lane], lane);
            const float li = 0.8f - 0.6f * expf(-0.3f * (float)l);
            if (lane == 0) { lamv[2 * l] = expf(s1) - expf(s2) + li; lamv[2 * l + 1] = 1.0f - li; }
        }
    }
}

struct NormRow { const float* hold; float* hnew; u32x4 r[2]; f32x4 ho[4]; bool live; bool meta; };
__device__ __forceinline__ void norm_load(const Args& a, int l, bool last, int row, int lane, const bf16_t* ob, float* metah, NormRow& R) {
    R.live = row < MROWS;
    const int rr = R.live ? row : MROWS - 1;
    int g, b, pos; row_decode(rr, g, b, pos);
    if (last && pos < 16) R.live = false;
    R.meta = pos < 16;
    if (pos < 16) { R.hnew = metah + ((size_t)(g * NB + b) * 16 + pos) * DM; R.hold = (l == 0) ? a.in[2] + (size_t)pos * DM : R.hnew; }
    else { const size_t off = (g ? (size_t)NB * SP * DM : 0) + ((size_t)b * (g ? SS : SP) + (pos - 16)) * DM; R.hnew = a.out + off;
           R.hold = (l == 0) ? (g ? a.in[1] : a.in[0]) + ((size_t)b * (g ? SS : SP) + (pos - 16)) * DM : R.hnew; }
#pragma unroll
    for (int j = 0; j < 2; ++j) R.r[j] = *(const u32x4*)(ob + (size_t)rr * DM + 512 * j + lane * 8);
    if (l == 0 || R.meta) {
#pragma unroll
        for (int j = 0; j < 4; ++j) R.ho[j] = *(const f32x4*)(R.hold + 512 * (j >> 1) + lane * 8 + 4 * (j & 1));
    } else {
        const bf16_t* hb = (const bf16_t*)R.hold;
#pragma unroll
        for (int j = 0; j < 2; ++j) {
            const u32x4 q = *(const u32x4*)(hb + 512 * j + lane * 8);
            R.ho[2 * j] = (f32x4){bf_lo(q.x), bf_hi(q.x), bf_lo(q.y), bf_hi(q.y)};
            R.ho[2 * j + 1] = (f32x4){bf_lo(q.z), bf_hi(q.z), bf_lo(q.w), bf_hi(q.w)};
        }
    }
}
__device__ __forceinline__ void norm_compute(const NormRow& R, int row, int lane, bool last, const f32x4 (&pgv)[4], const f32x4 (&prv)[4], bf16_t* hn) {
    if (!R.live) return;
    f32x4 ov[4]; float ss = 0.f;
#pragma unroll
    for (int j = 0; j < 2; ++j) {
        const u32x4 r = R.r[j];
        ov[2 * j] = (f32x4){bf_lo(r.x), bf_hi(r.x), bf_lo(r.y), bf_hi(r.y)};
        ov[2 * j + 1] = (f32x4){bf_lo(r.z), bf_hi(r.z), bf_lo(r.w), bf_hi(r.w)};
    }
#pragma unroll
    for (int j = 0; j < 4; ++j) ss += (ov[j][0] * ov[j][0] + ov[j][1] * ov[j][1]) + (ov[j][2] * ov[j][2] + ov[j][3] * ov[j][3]);
    const float rstd = __builtin_amdgcn_rsqf(wave_sum(ss, lane) * (1.0f / DM) + EPS);
    f32x4 hv[4]; float s2 = 0.f;
#pragma unroll
    for (int j = 0; j < 4; ++j) {
        const int c0 = 512 * (j >> 1) + lane * 8 + 4 * (j & 1);
        hv[j] = R.ho[j] + ov[j] * rstd * pgv[j];
        s2 += (hv[j][0] * hv[j][0] + hv[j][1] * hv[j][1]) + (hv[j][2] * hv[j][2] + hv[j][3] * hv[j][3]);
    }
    if (last || R.meta) {
#pragma unroll
        for (int j = 0; j < 4; ++j) { if (last) __builtin_nontemporal_store(hv[j], (f32x4*)(R.hnew + 512 * (j >> 1) + lane * 8 + 4 * (j & 1))); else *(f32x4*)(R.hnew + 512 * (j >> 1) + lane * 8 + 4 * (j & 1)) = hv[j]; }
    } else {
        bf16_t* hb = (bf16_t*)R.hnew;
#pragma unroll
        for (int j = 0; j < 2; ++j) {
            u32x4 o; o.x = cvtpk(hv[2 * j][0], hv[2 * j][1]); o.y = cvtpk(hv[2 * j][2], hv[2 * j][3]); o.z = cvtpk(hv[2 * j + 1][0], hv[2 * j + 1][1]); o.w = cvtpk(hv[2 * j + 1][2], hv[2 * j + 1][3]);
            __builtin_nontemporal_store(o, (u32x4*)(hb + 512 * j + lane * 8));
        }
    }
    if (!last) {
        const float rstd2 = __builtin_amdgcn_rsqf(wave_sum(s2, lane) * (1.0f / DM) + EPS);
#pragma unroll
        for (int j = 0; j < 2; ++j) {
            const int c0 = 512 * j + lane * 8;
            const f32x4 a0 = hv[2 * j] * rstd2 * prv[2 * j], a1 = hv[2 * j + 1] * rstd2 * prv[2 * j + 1];
            u32x4 o; o.x = cvtpk(a0[0], a0[1]); o.y = cvtpk(a0[2], a0[3]); o.z = cvtpk(a1[0], a1[1]); o.w = cvtpk(a1[2], a1[3]);
            *(u32x4*)(hn + (size_t)row * DM + c0) = o;
        }
    }
}
__device__ __forceinline__ void norm_phase(const Args& a, int l) {
    int tid_ = threadIdx.x; asm volatile("" : "+v"(tid_));
    const int tid = tid_, lane = tid & 63, wave = tid >> 6;
    const int gw = blockIdx.x * NWAVES + wave, NGW = gridDim.x * NWAVES;
    unsigned char* ws = a.ws;
    const bf16_t* ob = (const bf16_t*)(ws + WS_PROJ);
    bf16_t* hn = (bf16_t*)(ws + WS_HN);
    float* metah = (float*)(ws + WS_METAH);
    const float* postg = a.in[6] + (size_t)l * DM;
    const bool last = (l == DEPTH - 1);
    const float* preg = a.in[5] + (size_t)(last ? l : l + 1) * DM;
    f32x4 pgv[4], prv[4];
#pragma unroll
    for (int j = 0; j < 4; ++j) { const int c0 = 512 * (j >> 1) + lane * 8 + 4 * (j & 1); pgv[j] = *(const f32x4*)(postg + c0); prv[j] = *(const f32x4*)(preg + c0); }
    for (int row = gw; row < MROWS; row += 2 * NGW) {
        NormRow A, B;
        norm_load(a, l, last, row, lane, ob, metah, A);
        norm_load(a, l, last, row + NGW, lane, ob, metah, B);
        norm_compute(A, row, lane, last, pgv, prv, hn);
        norm_compute(B, row + NGW, lane, last, pgv, prv, hn);
    }
}

__global__ void __launch_bounds__(NWAVES * 64, 2) fwd_kernel(Args a) {
    extern __shared__ __attribute__((aligned(16))) unsigned char lds_raw[];
    LAS unsigned char* lds = (LAS unsigned char*)lds_raw;
    unsigned char* ws = a.ws;
#define IN(k) true
#define SEAM(k) do { ++nbar; grid_bar((unsigned*)(ws + WS_CTL) + 1024, nbar * gridDim.x); } while (0)
    unsigned nbar = 0;
    if (IN(0)) { prologue(a, lds); }
    cg::this_grid().sync();
    for (int l = 0; l < DEPTH; ++l) {
        const int p0 = 1 + 4 * l;
        if (IN(p0)) {
            pg8::Gemm g{(const bf16_t*)(ws + WS_HN), (const bf16_t*)(ws + WS_WIN) + (size_t)l * NIN * DM, MROWS, NIN, DM};
            pg8::StaticOrder S; S.init(MROWS, NIN, (int)gridDim.x, (int)blockIdx.x);
            pg8::EpiStore<true> E{(bf16_t*)(ws + WS_PROJ), NIN, (const f32x2*)(ws + WS_ROPE)};
            pg8::gemm_phase<pg8::EpiStore<true>, pg8::StaticOrder, true, true>(lds, g, S, E);
        }
        SEAM(p0);
        if (IN(p0 + 1)) {
            att::attn_phase(lds, (const bf16_t*)(ws + WS_PROJ), (bf16_t*)(ws + WS_HN), (float*)(ws + WS_STASH), (unsigned*)(ws + WS_CTL) + 2048 + 512 * l, l == DEPTH - 1,
                            (const float*)(ws + WS_LAM) + 2 * l, a.in[12] + (size_t)l * 128, a.in[7] + (size_t)l * 8);
        }
        SEAM(p0 + 1);
        if (IN(p0 + 2)) {
            pg8::Gemm g{(const bf16_t*)(ws + WS_HN), (const bf16_t*)(ws + WS_WOUT) + (size_t)l * DM * DM, MROWS, DM, DM};
            pg8::StaticOrder S; S.init(MROWS, DM, (int)gridDim.x, (int)blockIdx.x);
            pg8::EpiStore<false> E{(bf16_t*)(ws + WS_PROJ), DM, nullptr};
            pg8::gemm_phase<pg8::EpiStore<false>, pg8::StaticOrder, true, true>(lds, g, S, E);
        }
        SEAM(p0 + 2);
        if (IN(p0 + 3)) norm_phase(a, l);
        SEAM(p0 + 3);
    }
#undef IN
#undef SEAM
}

extern "C" void kernel_launch(void* const* d_in, const int* in_sizes, int n_in, void* d_out, int out_size, void* d_ws, size_t ws_size, hipStream_t stream) {
    static int grid = 0;
    if (grid == 0) {
        if (n_in != 13 || ws_size < WS_END) { fprintf(stderr, "kernel_launch: need 13 inputs and >= %zu bytes of workspace; got %d, %zu\n", (size_t)WS_END, n_in, ws_size); grid = -1; return; }
        int dev = 0, cus = 0, per_cu = 0;
        if (hipGetDevice(&dev) != hipSuccess || hipDeviceGetAttribute(&cus, hipDeviceAttributeMultiprocessorCount, dev) != hipSuccess) { grid = -1; return; }
        if (hipFuncSetAttribute((const void*)fwd_kernel, hipFuncAttributeMaxDynamicSharedMemorySize, LDS_BYTES) != hipSuccess) { fprintf(stderr, "kernel_launch: hipFuncSetAttribute failed\n"); grid = -1; return; }
        if (hipOccupancyMaxActiveBlocksPerMultiprocessor(&per_cu, (const void*)fwd_kernel, NWAVES * 64, LDS_BYTES) != hipSuccess || per_cu < 1) { fprintf(stderr, "kernel_launch: occupancy query says %d\n", per_cu); per_cu = 1; }
        (void)hipGetLastError();
        grid = cus * 1;
    }
    if (grid < 0) return;
    (void)hipMemsetAsync((char*)d_ws + WS_CTL, 0, CTL_BYTES, stream);
    Args a{};
    for (int i = 0; i < 13; ++i) a.in[i] = (const float*)d_in[i];
    a.out = (float*)d_out; a.ws = (unsigned char*)d_ws; a.ph_lo = 0; a.ph_hi = N_PHASES;
    void* args[] = {&a};
    hipError_t e = hipLaunchCooperativeKernel((const void*)fwd_kernel, dim3(grid), dim3(NWAVES * 64), args, LDS_BYTES, stream);
    if (e != hipSuccess) fprintf(stderr, "cooperative launch failed: %s (grid %d)\n", hipGetErrorString(e), grid);
}
```

```cpp
#include <hip/hip_runtime.h>
#include <hip/hip_cooperative_groups.h>
#include <cstdio>
#include <cstdint>
namespace cg = cooperative_groups;

constexpr int DM = 1024, NIN = 3328, NB = 16, DEPTH = 4;
constexpr int LP = 4112, LS = 2064, SP = 4096, SS = 2048;
constexpr int ROWS_P = NB * LP, ROWS_S = NB * LS, MROWS = ROWS_P + ROWS_S;
constexpr float EPS = 1e-6f;
constexpr int C_AQ = 0, C_AK = 512, C_AV = 640, C_AG = 768, C_BQ = 1280, C_BK = 1792, C_BV = 2304, C_BG = 2816;

constexpr size_t MiB = 1u << 20;
constexpr size_t WS_CTL = 0, CTL_BYTES = 65536;
constexpr size_t WS_LAM = 1 * MiB;
constexpr size_t WS_ROPE = 2 * MiB;
constexpr size_t WS_WIN = 4 * MiB;
constexpr size_t WS_WOUT = 30 * MiB;
constexpr size_t WS_METAH = 38 * MiB;
constexpr size_t WS_STASH = 40 * MiB;
constexpr size_t WS_HN = 72 * MiB;
constexpr size_t WS_PROJ = 266 * MiB;
constexpr size_t WS_END = 894 * MiB;

#define LAS __attribute__((address_space(3)))
typedef unsigned short bf16_t;
typedef short bf16x8 __attribute__((ext_vector_type(8)));
typedef short s16x4 __attribute__((ext_vector_type(4)));
typedef float f32x2 __attribute__((ext_vector_type(2)));
typedef float f32x4 __attribute__((ext_vector_type(4)));
typedef float f32x16 __attribute__((ext_vector_type(16)));
typedef unsigned u32x2 __attribute__((ext_vector_type(2)));
typedef unsigned u32x4 __attribute__((ext_vector_type(4)));

__device__ __forceinline__ unsigned cvtpk(float lo, float hi) {
    typedef __bf16 b2 __attribute__((ext_vector_type(2)));
    f32x2 v = {lo, hi}; b2 b = __builtin_convertvector(v, b2); return __builtin_bit_cast(unsigned, b);
}
__device__ __forceinline__ float bf_lo(unsigned u) { return __uint_as_float(u << 16); }
__device__ __forceinline__ float bf_hi(unsigned u) { return __uint_as_float(u & 0xffff0000u); }
__device__ __forceinline__ float wave_sum(float v, int lane) {
#pragma unroll
    for (int o = 1; o < 64; o <<= 1) v += __int_as_float(__builtin_amdgcn_ds_bpermute((lane ^ o) << 2, __float_as_int(v)));
    return v;
}
__device__ __forceinline__ void row_decode(int row, int& g, int& b, int& pos) {
    if (row < ROWS_P) { g = 0; b = row / LP; pos = row - b * LP; }
    else { const int r = row - ROWS_P; g = 1; b = r / LS; pos = r - b * LS; }
}

namespace pg8 {
#define PG8_LAS __attribute__((address_space(3)))
constexpr int BM = 256, BK = 64, HALF = 128, HTB = HALF * BK * 2  , STAGE_BYTES = 8 * HTB, NXCD = 8, WGM = 8;

__host__ __device__ __forceinline__ int lds_byte(int r, int c) { const int st = (r >> 4) * 2 + (c >> 5), rr = r & 15, cc = c & 31, ob = rr * 64 + cc * 2; return st * 1024 + (ob ^ (((ob >> 9) & 1) << 5)); }
__host__ __device__ __forceinline__ void stage_rc(int b, int& R, int& C) { const int st = b / 1024, sb = b % 1024, swz = sb ^ (((sb >> 9) & 1) << 5); R = (st >> 1) * 16 + swz / 64; C = (st & 1) * 32 + (swz % 64) / 2; }
__host__ __device__ __forceinline__ int perm32(int rho) { const int n = rho >> 4, i = rho & 15; return 8 * (i >> 2) + 4 * n + (i & 3); }

struct Unit { int pm, pn; };
struct Gemm { const bf16_t* A; const bf16_t* Bt; int M, N, K; };

struct StaticOrder {
    int nM, nN, nwg, G, c;
    __host__ __device__ void init(int M, int N, int G_, int c_) { nM = M / BM; nN = N / BM; nwg = nM * nN; G = G_; c = c_; }
    __host__ __device__ bool next(int i, Unit& u) const {
        const long L = (long)i * G + c; if (L >= nwg) return false;
        int wgid = (int)L; { const int q = nwg / NXCD, r = nwg % NXCD, xcd = wgid % NXCD, off = wgid / NXCD; wgid = (xcd < r ? xcd * (q + 1) : r * (q + 1) + (xcd - r) * q) + off; }
        const int nig = WGM * nN, gid = wgid / nig, fm = gid * WGM, gsz = (nM - fm) < WGM ? (nM - fm) : WGM;
        u.pm = fm + ((wgid % nig) % gsz); u.pn = (wgid % nig) / gsz; return true;
    }
    __device__ __forceinline__ void a_ready(const Unit&) const {}
    __device__ __forceinline__ void done(const Unit&) const {}
};

template <bool ROPE> struct EpiStore {
    static constexpr bool PERM = true, AFTER_DRAIN = false;
    bf16_t* O; int ldc; const f32x2* rope;
    __device__ __forceinline__ void operator()(const f32x4 (&acc)[2][2][4][2], const Unit& u, int wr, int wc, int fr, int fq) const {
        const int row0 = u.pm * BM + wr * 64 + fr; const int col0 = u.pn * BM + wc * 32 + 8 * fq;
#pragma unroll
        for (int ai = 0; ai < 2; ++ai)
#pragma unroll
            for (int m = 0; m < 4; ++m) {
                const int row = row0 + ai * HALF + m * 16;
                bf16_t* rowp = O + (size_t)row * ldc + col0;
                int pos = 0;
                if (ROPE) { int g, b; row_decode(row, g, b, pos); }
#pragma unroll
                for (int bj = 0; bj < 2; ++bj) {
                    f32x4 v0 = acc[ai][bj][m][0], v1 = acc[ai][bj][m][1];
                    if (ROPE) {
                        const int half = 2 * u.pn + bj;
                        const bool dorope = (half < 5) || (half >= 10 && half < 18);
                        if (dorope) {
                            const int i0 = ((col0 + bj * HALF) & 63) >> 1;
                            const f32x4* rp = (const f32x4*)(rope + (size_t)pos * 32 + i0);
                            const f32x4 cs0 = rp[0], cs1 = rp[1];
                            f32x4 w0, w1;
                            w0[0] = (v0[0] * cs0[0] - v0[1] * cs0[1]); w0[1] = (v0[1] * cs0[0] + v0[0] * cs0[1]);
                            w0[2] = (v0[2] * cs0[2] - v0[3] * cs0[3]); w0[3] = (v0[3] * cs0[2] + v0[2] * cs0[3]);
                            w1[0] = (v1[0] * cs1[0] - v1[1] * cs1[1]); w1[1] = (v1[1] * cs1[0] + v1[0] * cs1[1]);
                            w1[2] = (v1[2] * cs1[2] - v1[3] * cs1[3]); w1[3] = (v1[3] * cs1[2] + v1[2] * cs1[3]);
                            v0 = w0; v1 = w1;
                        }
                    }
                    u32x4 w; w.x = cvtpk(v0[0], v0[1]); w.y = cvtpk(v0[2], v0[3]); w.z = cvtpk(v1[0], v1[1]); w.w = cvtpk(v1[2], v1[3]);
                    *(u32x4*)(rowp + bj * HALF) = w;
                }
            }
    }
};

template <class Epi, class Sched, bool ALIGN_EPI = false, bool SP2 = false>
__device__ __forceinline__ void gemm_phase(PG8_LAS unsigned char* lds, const Gemm g, const Sched& S, const Epi& E) {
    int tid_ = threadIdx.x; asm volatile("" : "+v"(tid_));
    const int tid = tid_, wid = __builtin_amdgcn_readfirstlane(tid >> 6), lane = tid & 63, wr = wid >> 2, wc = wid & 3, fr = lane & 15, fq = lane >> 4;
    const int K = g.K, nt = K / BK;
    unsigned voffA[2], voffB[2];
#pragma unroll
    for (int i = 0; i < 2; ++i) { int R, C; stage_rc(tid * 16 + i * 8192, R, C); const int Rb = Epi::PERM ? ((R & ~31) + perm32(R & 31)) : R;
        voffA[i] = (unsigned)(R * K + C) * 2u; voffB[i] = (unsigned)(Rb * K + C) * 2u; }
    const size_t kstep = (size_t)(BK * 2);
    const size_t hstep = (size_t)HALF * K * 2;
    const size_t tstep = 2 * hstep;
    const unsigned ldsw = (unsigned)wid * 1024u;
    const int aoff = lds_byte(wr * 64 + fr, fq * 8), boff = lds_byte(wc * 32 + fr, fq * 8);
#define PG8_SA(b, h) (((b) * 2 + (h)) * HTB)
#define PG8_SB(b, h) ((4 + (b) * 2 + (h)) * HTB)
#define PG8_STAGE(bufoff, gbase, voff) do { _Pragma("unroll") for (int _i = 0; _i < 2; ++_i) \
        __builtin_amdgcn_global_load_lds((const unsigned*)((const char*)(gbase) + (voff)[_i]), (PG8_LAS unsigned*)(lds + (bufoff) + ldsw + _i * 8192), 16, 0, 0); } while (0)
#define PG8_LDA(dst, b, h) do { _Pragma("unroll") for (int m = 0; m < 4; ++m) _Pragma("unroll") for (int k = 0; k < 2; ++k) dst[m][k] = *(const PG8_LAS bf16x8*)(lds + PG8_SA(b, h) + aoff + m * 2048 + k * 1024); } while (0)
#define PG8_LDB(dst, b, h) do { _Pragma("unroll") for (int n = 0; n < 2; ++n) _Pragma("unroll") for (int k = 0; k < 2; ++k) dst[n][k] = *(const PG8_LAS bf16x8*)(lds + PG8_SB(b, h) + boff + n * 2048 + k * 1024); } while (0)
#define PG8_MMA(ai, bj, At, Bt) do { __builtin_amdgcn_s_setprio(1); _Pragma("unroll") for (int m = 0; m < 4; ++m) _Pragma("unroll") for (int n = 0; n < 2; ++n) _Pragma("unroll") for (int k = 0; k < 2; ++k) \
        acc[ai][bj][m][n] = __builtin_amdgcn_mfma_f32_16x16x32_bf16(Bt[n][k], At[m][k], acc[ai][bj][m][n], 0, 0, 0); __builtin_amdgcn_s_setprio(0); } while (0)
#define PG8_WAIT_V(n) asm volatile("s_waitcnt vmcnt(" #n ")" ::: "memory")
#define PG8_WAIT_L(n) asm volatile("s_waitcnt lgkmcnt(" #n ")" ::: "memory")
#define PG8_BAR __builtin_amdgcn_s_barrier()
#define PG8_SCHED __builtin_amdgcn_sched_barrier(0)
    Unit cur, nxt; int ui = 0;
    (void)S.next(0, cur);
    f32x4 acc[2][2][4][2];
#pragma unroll
    for (int a = 0; a < 2; ++a)
#pragma unroll
        for (int b = 0; b < 2; ++b)
#pragma unroll
            for (int m = 0; m < 4; ++m)
#pragma unroll
                for (int n = 0; n < 2; ++n) acc[a][b][m][n] = (f32x4){0.f, 0.f, 0.f, 0.f};
    bf16x8 At[4][2], B0[2][2], B1[2][2];
    const char* cA = (const char*)g.A + (size_t)cur.pm * tstep; const char* cB = (const char*)g.Bt + (size_t)cur.pn * tstep;
    S.a_ready(cur);
    if constexpr (SP2) {
        PG8_STAGE(PG8_SB(0, 0), cB, voffB); PG8_STAGE(PG8_SB(0, 1), cB + hstep, voffB); PG8_STAGE(PG8_SA(0, 0), cA, voffA); PG8_STAGE(PG8_SA(0, 1), cA + hstep, voffA);
        if (wr == 1) PG8_BAR;
        PG8_WAIT_V(2); PG8_BAR;
        PG8_STAGE(PG8_SB(1, 0), cB + kstep, voffB); PG8_STAGE(PG8_SA(1, 0), cA + kstep, voffA); PG8_STAGE(PG8_SB(1, 1), cB + hstep + kstep, voffB);
        PG8_WAIT_V(6); PG8_BAR;
    } else {
        PG8_STAGE(PG8_SB(0, 0), cB, voffB); PG8_STAGE(PG8_SA(0, 0), cA, voffA); PG8_STAGE(PG8_SB(0, 1), cB + hstep, voffB); PG8_STAGE(PG8_SA(0, 1), cA + hstep, voffA);
        if (wr == 1) PG8_BAR;
        PG8_WAIT_V(4); PG8_BAR;
        PG8_STAGE(PG8_SB(1, 0), cB + kstep, voffB); PG8_STAGE(PG8_SA(1, 0), cA + kstep, voffA); PG8_STAGE(PG8_SB(1, 1), cB + hstep + kstep, voffB);
        PG8_WAIT_V(6); PG8_BAR;
    }
    for (;;) {
        const bool has_next = S.next(ui + 1, nxt);
        const char* nA = has_next ? (const char*)g.A + (size_t)nxt.pm * tstep : cA; const char* nB = has_next ? (const char*)g.Bt + (size_t)nxt.pn * tstep : cB;
        for (int t = 0; t < nt; t += 2) {
            const bool last = (t == nt - 2);
            const char* a1 = cA + (size_t)(t + 1) * kstep;
            const char* a2 = last ? nA : cA + (size_t)(t + 2) * kstep; const char* b2 = last ? nB : cB + (size_t)(t + 2) * kstep;
            const char* a3 = a2 + kstep; const char* b3 = b2 + kstep;
            if (last && has_next) S.a_ready(nxt);
            if constexpr (SP2) {
            PG8_LDB(B0, 0, 0); PG8_LDB(B1, 0, 1); PG8_SCHED; PG8_LDA(At, 0, 0); PG8_STAGE(PG8_SA(1, 1), a1 + hstep, voffA);
            PG8_WAIT_V(8); PG8_WAIT_L(0); PG8_BAR; PG8_MMA(0, 0, At, B0); PG8_MMA(0, 1, At, B1); PG8_BAR; PG8_SCHED;
            PG8_LDA(At, 0, 1); PG8_STAGE(PG8_SB(0, 0), b2, voffB); PG8_STAGE(PG8_SB(0, 1), b2 + hstep, voffB); PG8_STAGE(PG8_SA(0, 0), a2, voffA);
            PG8_WAIT_V(8); PG8_WAIT_L(0); PG8_BAR; PG8_MMA(1, 0, At, B0); PG8_MMA(1, 1, At, B1); PG8_BAR; PG8_SCHED;
            PG8_LDB(B0, 1, 0); PG8_LDB(B1, 1, 1); PG8_SCHED; PG8_LDA(At, 1, 0); PG8_STAGE(PG8_SA(0, 1), a2 + hstep, voffA);
            PG8_WAIT_V(8); PG8_WAIT_L(0); PG8_BAR; PG8_MMA(0, 0, At, B0); PG8_MMA(0, 1, At, B1); PG8_BAR; PG8_SCHED;
            PG8_LDA(At, 1, 1); PG8_STAGE(PG8_SB(1, 0), b3, voffB); PG8_STAGE(PG8_SB(1, 1), b3 + hstep, voffB); PG8_STAGE(PG8_SA(1, 0), a3, voffA);
            PG8_WAIT_V(8); PG8_WAIT_L(0); PG8_BAR; PG8_MMA(1, 0, At, B0); PG8_MMA(1, 1, At, B1); PG8_BAR; PG8_SCHED;
            } else {
            PG8_LDB(B0, 0, 0); PG8_SCHED; PG8_LDA(At, 0, 0); PG8_STAGE(PG8_SA(1, 1), a1 + hstep, voffA);
            PG8_WAIT_L(8); PG8_BAR; PG8_WAIT_L(0); PG8_MMA(0, 0, At, B0); PG8_BAR; PG8_SCHED;
            PG8_LDB(B1, 0, 1); PG8_STAGE(PG8_SB(0, 0), b2, voffB);
            PG8_BAR; PG8_WAIT_L(0); PG8_MMA(0, 1, At, B1); PG8_BAR;
            PG8_LDA(At, 0, 1); PG8_STAGE(PG8_SA(0, 0), a2, voffA);
            PG8_BAR; PG8_WAIT_L(0); PG8_MMA(1, 0, At, B0); PG8_BAR; PG8_SCHED;
            PG8_STAGE(PG8_SB(0, 1), b2 + hstep, voffB);
            PG8_WAIT_V(6); PG8_BAR; PG8_MMA(1, 1, At, B1); PG8_BAR;
            PG8_LDB(B0, 1, 0); PG8_SCHED; PG8_LDA(At, 1, 0); PG8_STAGE(PG8_SA(0, 1), a2 + hstep, voffA);
            PG8_WAIT_L(8); PG8_BAR; PG8_WAIT_L(0); PG8_MMA(0, 0, At, B0); PG8_BAR; PG8_SCHED;
            PG8_LDB(B1, 1, 1); PG8_STAGE(PG8_SB(1, 0), b3, voffB);
            PG8_BAR; PG8_WAIT_L(0); PG8_MMA(0, 1, At, B1); PG8_BAR;
            PG8_LDA(At, 1, 1); PG8_STAGE(PG8_SA(1, 0), a3, voffA);
            PG8_BAR; PG8_WAIT_L(0); PG8_MMA(1, 0, At, B0); PG8_BAR; PG8_SCHED;
            PG8_STAGE(PG8_SB(1, 1), b3 + hstep, voffB);
            PG8_WAIT_V(6); PG8_BAR; PG8_MMA(1, 1, At, B1); PG8_BAR;
            }
        }
        if constexpr (ALIGN_EPI) { if (wr == 0) PG8_BAR; }
        if constexpr (!Epi::AFTER_DRAIN) { E(acc, cur, wr, wc, fr, fq); S.done(cur); }
        if (!has_next) break;
#pragma unroll
        for (int a = 0; a < 2; ++a)
#pragma unroll
            for (int b = 0; b < 2; ++b)
#pragma unroll
                for (int m = 0; m < 4; ++m)
#pragma unroll
                    for (int n = 0; n < 2; ++n) acc[a][b][m][n] = (f32x4){0.f, 0.f, 0.f, 0.f};
        cur = nxt; cA = nA; cB = nB; ++ui;
        if constexpr (ALIGN_EPI) { if (wr == 1) PG8_BAR; }
    }
    PG8_WAIT_V(0);
    if constexpr (!ALIGN_EPI) { if (wr == 0) PG8_BAR; }
    PG8_BAR;
    if constexpr (Epi::AFTER_DRAIN) { E.fused(acc, cur, wr, wc, fr, fq, lds, wid, lane); S.done(cur); }
#undef PG8_SA
#undef PG8_SB
#undef PG8_STAGE
#undef PG8_LDA
#undef PG8_LDB
#undef PG8_MMA
#undef PG8_WAIT_V
#undef PG8_WAIT_L
#undef PG8_BAR
#undef PG8_SCHED
}
}

namespace att {
typedef short v4i16_t __attribute__((ext_vector_type(4)));
typedef LAS const unsigned char* lcp;
constexpr float NEG = -1.0e30f;
constexpr float LOG2E = 1.4426950408889634f;
constexpr int KP = 144, VP128 = 320, VP64 = 192;
constexpr int KBUF = 64 * KP, VBUF = 64 * VP128;
constexpr int SW_K = 0, SW_V = 24576;
constexpr int OFF_K0 = 0, OFF_K1 = KBUF, OFF_V0 = 2 * KBUF, OFF_V1 = 2 * KBUF + VBUF, OFF_UNIT = 131072;
enum { K_NONE = 0, K_DENSE = 1, K_META = 2, K_BAND = 3, K_METAQ = 4 };

__device__ __forceinline__ int crow(int i, int h) { return (i & 3) + 8 * (i >> 2) + 4 * h; }
__device__ __forceinline__ float swapmax(float v) { auto rr = __builtin_amdgcn_permlane32_swap(__float_as_uint(v), __float_as_uint(v), false, false); return fmaxf(__uint_as_float(rr[0]), __uint_as_float(rr[1])); }
__device__ __forceinline__ float swapsum(float v) { auto rr = __builtin_amdgcn_permlane32_swap(__float_as_uint(v), __float_as_uint(v), false, false); return __uint_as_float(rr[0]) + __uint_as_float(rr[1]); }
__device__ __forceinline__ s16x4 vtr(lcp p) { return __builtin_bit_cast(s16x4, __builtin_amdgcn_ds_read_tr16_b64_v4i16((LAS v4i16_t*)p)); }
__device__ __forceinline__ float max3f(float a, float b, float c) { float r; asm("v_max3_f32 %0, %1, %2, %3" : "=v"(r) : "v"(a), "v"(b), "v"(c)); return r; }
__device__ __forceinline__ float ex2(float x) { return __builtin_amdgcn_exp2f(x); }
__device__ __forceinline__ float silu(float x) { return x * __builtin_amdgcn_rcpf(1.0f + ex2(-x * LOG2E)); }

template <int KIND> __device__ __forceinline__ bool kvalid(int kr, int lim, int qi) {
    if (KIND == K_DENSE) return kr < lim;
    if (KIND == K_META) return kr < 16;
    if (KIND == K_BAND) { const int u = kr - 16; const int d = u - qi; return (unsigned)u < (unsigned)lim && d <= 128 && d >= -128; }
    if (KIND == K_METAQ) { const int u = kr - 16; return kr < 16 || (u < 128 && u <= 112 + qi); }
    return true;
}

template <int DV, int KIND>
__device__ __forceinline__ void tile_compute(f32x16 (&o)[DV / 32], float& m, float& l, const bf16x8 (&qf)[4], lcp kb, lcp vb, int r0, int h, int lim, int qi) {
    constexpr int VP = (DV == 128) ? VP128 : VP64;
    f32x16 s0, s1;
#pragma unroll
    for (int i = 0; i < 16; ++i) { s0[i] = 0.f; s1[i] = 0.f; }
#pragma unroll
    for (int ks = 0; ks < 4; ++ks) {
        const bf16x8 k0 = *(LAS const bf16x8*)(kb + ks * 32);
        const bf16x8 k1 = *(LAS const bf16x8*)(kb + 32 * KP + ks * 32);
        s0 = __builtin_amdgcn_mfma_f32_32x32x16_bf16(k0, qf[ks], s0, 0, 0, 0);
        s1 = __builtin_amdgcn_mfma_f32_32x32x16_bf16(k1, qf[ks], s1, 0, 0, 0);
        if (ks == 1) __builtin_amdgcn_sched_barrier(0);
    }
    if (KIND != K_NONE) {
        int hb = 4 * h + r0; asm volatile("" : "+v"(hb));
#pragma unroll
        for (int i = 0; i < 16; ++i) {
            const int kr = hb + (i & 3) + 8 * (i >> 2);
            s0[i] = kvalid<KIND>(kr, lim, qi) ? s0[i] : NEG;
            s1[i] = kvalid<KIND>(kr + 32, lim, qi) ? s1[i] : NEG;
        }
    }
    float mx = fmaxf(s0[0], s1[0]);
#pragma unroll
    for (int i = 1; i < 16; ++i) mx = fmaxf(mx, fmaxf(s0[i], s1[i]));
    mx = swapmax(mx);
    const float mn = fmaxf(m, mx);
    const float alpha = ex2(m - mn);
    m = mn;
    float rs = 0.f;
#pragma unroll
    for (int i = 0; i < 16; ++i) { s0[i] = ex2(s0[i] - mn); s1[i] = ex2(s1[i] - mn); rs += s0[i] + s1[i]; }
    l = l * alpha + rs;
#pragma unroll
    for (int c = 0; c < DV / 32; ++c)
#pragma unroll
        for (int i = 0; i < 16; ++i) o[c][i] *= alpha;
    bf16x8 pf[4];
    {
        u32x4 w;
        w.x = cvtpk(s0[0], s0[1]); w.y = cvtpk(s0[2], s0[3]); w.z = cvtpk(s0[4], s0[5]); w.w = cvtpk(s0[6], s0[7]); pf[0] = __builtin_bit_cast(bf16x8, w);
        w.x = cvtpk(s0[8], s0[9]); w.y = cvtpk(s0[10], s0[11]); w.z = cvtpk(s0[12], s0[13]); w.w = cvtpk(s0[14], s0[15]); pf[1] = __builtin_bit_cast(bf16x8, w);
        w.x = cvtpk(s1[0], s1[1]); w.y = cvtpk(s1[2], s1[3]); w.z = cvtpk(s1[4], s1[5]); w.w = cvtpk(s1[6], s1[7]); pf[2] = __builtin_bit_cast(bf16x8, w);
        w.x = cvtpk(s1[8], s1[9]); w.y = cvtpk(s1[10], s1[11]); w.z = cvtpk(s1[12], s1[13]); w.w = cvtpk(s1[14], s1[15]); pf[3] = __builtin_bit_cast(bf16x8, w);
    }
    constexpr int NC = DV / 32;
#pragma unroll
    for (int kk = 0; kk < 4; ++kk) {
        s16x4 alo[NC], ahi[NC];
#pragma unroll
        for (int c = 0; c < NC; ++c) { alo[c] = vtr(vb + (16 * kk) * VP + c * 64); ahi[c] = vtr(vb + (16 * kk + 8) * VP + c * 64); }
#pragma unroll
        for (int c = 0; c < NC; ++c) {
            const s16x4 lo = alo[c], hi = ahi[c];
            const bf16x8 a = {lo[0], lo[1], lo[2], lo[3], hi[0], hi[1], hi[2], hi[3]};
            o[c] = __builtin_amdgcn_mfma_f32_32x32x16_bf16(a, pf[kk], o[c], 0, 0, 0);
        }
        __builtin_amdgcn_sched_barrier(0);
    }
}

__device__ __forceinline__ bf16x8 pack8(const f32x16& s, int b) {
    u32x4 w; w.x = cvtpk(s[b], s[b + 1]); w.y = cvtpk(s[b + 2], s[b + 3]); w.z = cvtpk(s[b + 4], s[b + 5]); w.w = cvtpk(s[b + 6], s[b + 7]); return __builtin_bit_cast(bf16x8, w);
}
__device__ __forceinline__ void exp_pv_sw(f32x16 (&o)[4], float m, float& l, f32x16& s0, f32x16& s1, lcp vl, int vB0, int vB1, int q4) {
    const lcp vb0[4] = {vl + vB0 + ((0 ^ q4) << 6), vl + vB0 + ((1 ^ q4) << 6), vl + vB0 + ((2 ^ q4) << 6), vl + vB0 + ((3 ^ q4) << 6)};
    const lcp vb1[4] = {vl + vB1 + ((0 ^ q4) << 6), vl + vB1 + ((1 ^ q4) << 6), vl + vB1 + ((2 ^ q4) << 6), vl + vB1 + ((3 ^ q4) << 6)};
    s16x4 alo[2][4], ahi[2][4];
#define VLOAD(kk, b) do { _Pragma("unroll") for (int c = 0; c < 4; ++c) { alo[b][c] = vtr(vb0[c] + 4096 * (kk)); ahi[b][c] = vtr(vb1[c] + 4096 * (kk)); } } while (0)
#define PVMMA(b, P) do { _Pragma("unroll") for (int c = 0; c < 4; ++c) { const s16x4 lo = alo[b][c], hi = ahi[b][c]; const bf16x8 a = {lo[0], lo[1], lo[2], lo[3], hi[0], hi[1], hi[2], hi[3]}; \
            o[c] = __builtin_amdgcn_mfma_f32_32x32x16_bf16(a, (P), o[c], 0, 0, 0); } } while (0)
#define EXP8(S, b0) do { _Pragma("unroll") for (int i = (b0); i < (b0) + 8; ++i) { S[i] = ex2(S[i]); rs += S[i]; } } while (0)
    float rs = 0.f;
    VLOAD(0, 0);
    EXP8(s0, 0); const bf16x8 p0 = pack8(s0, 0);
    __builtin_amdgcn_sched_barrier(0);
    VLOAD(1, 1); PVMMA(0, p0);
    EXP8(s0, 8); const bf16x8 p1 = pack8(s0, 8);
    __builtin_amdgcn_sched_barrier(0);
    VLOAD(2, 0); PVMMA(1, p1);
    EXP8(s1, 0); const bf16x8 p2 = pack8(s1, 0);
    __builtin_amdgcn_sched_barrier(0);
    VLOAD(3, 1); PVMMA(0, p2);
    EXP8(s1, 8); const bf16x8 p3 = pack8(s1, 8);
    __builtin_amdgcn_sched_barrier(0);
    PVMMA(1, p3);
    l += rs;
    __builtin_amdgcn_sched_barrier(0);
#undef VLOAD
#undef PVMMA
#undef EXP8
}
__device__ __forceinline__ void tile_sw(f32x16 (&o)[4], float& m, float& l, f32x16& negm, const bf16x8 (&qf)[4], lcp kb, int kx, lcp vl, int vB0, int vB1, int q4, int r0, int h, int lim, bool masked, bool first) {
    f32x16 s0, s1;
    bf16x8 kf[4][2];
#pragma unroll
    for (int ks = 0; ks < 4; ++ks) { kf[ks][0] = *(LAS const bf16x8*)(kb + (kx ^ (ks << 5))); kf[ks][1] = *(LAS const bf16x8*)(kb + (kx ^ (ks << 5)) + 4096); }
    __builtin_amdgcn_sched_barrier(0);
#pragma unroll
    for (int ks = 0; ks < 4; ++ks) {
        if (ks == 0) { s0 = __builtin_amdgcn_mfma_f32_32x32x16_bf16(kf[0][0], qf[0], negm, 0, 0, 0); s1 = __builtin_amdgcn_mfma_f32_32x32x16_bf16(kf[0][1], qf[0], negm, 0, 0, 0); }
        else { s0 = __builtin_amdgcn_mfma_f32_32x32x16_bf16(kf[ks][0], qf[ks], s0, 0, 0, 0); s1 = __builtin_amdgcn_mfma_f32_32x32x16_bf16(kf[ks][1], qf[ks], s1, 0, 0, 0); }
    }
    if (masked) {
        int hb = 4 * h + r0; asm volatile("" : "+v"(hb));
#pragma unroll
        for (int i = 0; i < 16; ++i) {
            const int kr = hb + (i & 3) + 8 * (i >> 2);
            s0[i] = kr < lim ? s0[i] : NEG;
            s1[i] = kr + 32 < lim ? s1[i] : NEG;
        }
    }
    asm volatile("s_nop 15" : "+v"(s0), "+v"(s1));
    float mxa = max3f(s0[0], s0[1], s1[0]), mxb = max3f(s0[2], s0[3], s1[1]);
    mxa = max3f(mxa, s1[2], s1[3]);
#pragma unroll
    for (int i = 4; i < 16; i += 4) { mxa = max3f(mxa, s0[i], s0[i + 1]); mxb = max3f(mxb, s0[i + 2], s0[i + 3]); mxa = max3f(mxa, s1[i], s1[i + 1]); mxb = max3f(mxb, s1[i + 2], s1[i + 3]); }
    float mx = max3f(mxa, mxb, mxb);
    mx = swapmax(mx);
    if (first || __builtin_amdgcn_ballot_w64(mx > 8.0f) != 0ull) {
        const float delta = first ? mx : fmaxf(mx, 0.f);
        const float alpha = first ? 1.0f : ex2(-delta);
        m += delta; l *= alpha;
#pragma unroll
        for (int c = 0; c < 4; ++c)
#pragma unroll
            for (int i = 0; i < 16; ++i) asm volatile("v_mul_f32 %0, %1, %0" : "+v"(o[c][i]) : "v"(alpha));
#pragma unroll
        for (int i = 0; i < 16; ++i) { s0[i] -= delta; s1[i] -= delta; negm[i] = -m; }
    }
    exp_pv_sw(o, m, l, s0, s1, vl, vB0, vB1, q4);
}

__device__ __forceinline__ void glds16(const void* gsrc, unsigned lds_dst) {
    unsigned keep;
    asm volatile("s_mov_b32 %0, m0\n\ts_mov_b32 m0, %2\n\ts_nop 0\n\tglobal_load_lds_dwordx4 %1, off\n\ts_mov_b32 m0, %0" : "=&s"(keep) : "v"(gsrc), "s"(lds_dst) : "memory");
}
__device__ __forceinline__ int clampi(int v, int lo, int hi) { return v < lo ? lo : (v > hi ? hi : v); }

__device__ __forceinline__ void diff_unit(LAS unsigned char* lds, const bf16_t* __restrict__ proj, bf16_t* __restrict__ aout, float* __restrict__ stash,
                                          int g, int b, int hh, int qb, const float* __restrict__ lamp, const float* __restrict__ subg) {
    int tid_ = threadIdx.x; asm volatile("" : "+v"(tid_));
    const int tid = tid_, lane = tid & 63, r32 = lane & 31, h = lane >> 5;
    const int w = __builtin_amdgcn_readfirstlane(tid >> 6);
    const int L = g ? LS : LP, brow0 = g ? ROWS_P + b * LS : b * LP, NT = (L + 63) >> 6;
    const bool active = (qb >= 0) || (w == 0);
    const int qrow = (qb >= 0) ? 16 + 256 * qb + 32 * w + r32 : r32;
    const bool rowvalid = (qb >= 0) || (r32 < 16);
    const int kkey = 8 * w + (lane >> 3), kchunk = (lane & 7) ^ ((kkey >> 1) & 7);
    const int vkey0 = 8 * w + (lane >> 4), vkey1 = vkey0 + 4;
    const int vchunk0 = (lane & 15) ^ (((vkey0 & 3) << 2) | ((vkey0 >> 2) & 3)), vchunk1 = (lane & 15) ^ (((vkey1 & 3) << 2) | ((vkey1 >> 2) & 3));
    const bf16_t* kbase = proj + (size_t)brow0 * NIN + C_BK + hh * 128 + kchunk * 8;
    const bf16_t* vbase0 = proj + (size_t)brow0 * NIN + C_BV + hh * 128 + vchunk0 * 8;
    const bf16_t* vbase1 = proj + (size_t)brow0 * NIN + C_BV + hh * 128 + vchunk1 * 8;
    const int fsw = (r32 >> 1) & 7;
    const lcp kb = (lcp)lds + r32 * 128 + ((h ^ (fsw & 1)) * 16);
    const int kx = (fsw >> 1) << 5;
    const int q4 = (lane & 15) >> 2, blk = (lane >> 4) & 1, p4 = lane & 3;
    const int vB0 = (4 * h + q4) * 256 + (((2 * blk + (p4 >> 1)) ^ h) * 16) + 8 * (p4 & 1);
    const int vB1 = (vB0 ^ 32) + 2048;

    f32x16 o[4]; float m = 0.f, l = 0.f; bf16x8 qf[4]; f32x16 negm;
#pragma unroll
    for (int i = 0; i < 16; ++i) negm[i] = 0.f;
#pragma unroll
    for (int c = 0; c < 4; ++c)
#pragma unroll
        for (int i = 0; i < 16; ++i) o[c][i] = 0.f;
    const int total = 2 * NT;
    const unsigned ldsw_k = (unsigned)w * 1024u, ldsw_v = (unsigned)w * 2048u;
    const unsigned lds0 = (unsigned)(size_t)lds;
    const bf16_t* kp = kbase + (size_t)kkey * NIN; const bf16_t* vp0 = vbase0 + (size_t)vkey0 * NIN; const bf16_t* vp1 = vbase1 + (size_t)vkey1 * NIN;
#define DIFF_DMA(tn, kslot, vslot) do { \
        glds16(kp, (unsigned)__builtin_amdgcn_readfirstlane(lds0 + SW_K + (kslot) * 8192 + ldsw_k)); \
        glds16(vp0, (unsigned)__builtin_amdgcn_readfirstlane(lds0 + SW_V + (vslot) * 16384 + ldsw_v)); \
        glds16(vp1, (unsigned)__builtin_amdgcn_readfirstlane(lds0 + SW_V + (vslot) * 16384 + ldsw_v + 1024u)); \
        { const bool wrap_ = ((tn) + 1 == NT);                   \
          const long dk_ = wrap_ ? (long)64 - (long)(NT - 1) * 64 * NIN : (long)64 * NIN, dv_ = wrap_ ? -(long)(NT - 1) * 64 * NIN : (long)64 * NIN; \
          kp += dk_; vp0 += dv_; vp1 += dv_; } } while (0)
    DIFF_DMA(0, 0, 0); DIFF_DMA(1, 1, 1);
    asm volatile("s_waitcnt vmcnt(3)" ::: "memory");
    __builtin_amdgcn_s_barrier(); asm volatile("" ::: "memory");
    int k_cur = 0, k_nn = 2, v_cur = 0, v_nn = 2;
    for (int t = 0; t < total; ++t) {
        const int c = t >= NT ? 1 : 0, tt = t - c * NT;
        if (tt == 0) {
            if (c == 1 && active) {
                const float inv = __builtin_amdgcn_rcpf(swapsum(l));
                int td = tid; asm volatile("" : "+v"(td));
                float* sp = stash + ((size_t)blockIdx.x * 512 + (td & ~63)) * 64 + (td & 63) * 4;
#pragma unroll
                for (int cc = 0; cc < 4; ++cc)
#pragma unroll
                    for (int g4 = 0; g4 < 4; ++g4) {
                        f32x4 v = {o[cc][4 * g4] * inv, o[cc][4 * g4 + 1] * inv, o[cc][4 * g4 + 2] * inv, o[cc][4 * g4 + 3] * inv};
                        *(f32x4*)(sp + (cc * 4 + g4) * 256) = v;
                        o[cc][4 * g4] = 0.f; o[cc][4 * g4 + 1] = 0.f; o[cc][4 * g4 + 2] = 0.f; o[cc][4 * g4 + 3] = 0.f;
                    }
                m = 0.f; l = 0.f;
#pragma unroll
                for (int i = 0; i < 16; ++i) negm[i] = 0.f;
            }
            int qr = qrow; asm volatile("" : "+v"(qr));
            const bf16_t* qp = proj + (size_t)(brow0 + qr) * NIN + C_BQ + hh * 128 + h * 8 + c * 64;
#pragma unroll
            for (int ks = 0; ks < 4; ++ks) qf[ks] = *(const bf16x8*)(qp + ks * 16);
            asm volatile("" : "+v"(qf[0]), "+v"(qf[1]), "+v"(qf[2]), "+v"(qf[3]) :: "memory");
        }
        if (t + 2 < total) DIFF_DMA(t + 2, k_nn, v_nn);
        if (active) {
            const int bo_k = SW_K + k_cur * 8192;
            const lcp vl = (lcp)lds + SW_V + v_cur * 16384;
            tile_sw(o, m, l, negm, qf, kb + bo_k, kx, vl, vB0, vB1, q4, 64 * tt, h, L, tt == NT - 1, tt == 0);
        }
        if (t + 2 < total) asm volatile("s_waitcnt vmcnt(3)" ::: "memory"); else asm volatile("s_waitcnt vmcnt(0)" ::: "memory");
        __builtin_amdgcn_s_barrier(); asm volatile("" ::: "memory");
        k_cur = (k_cur == 2) ? 0 : k_cur + 1; k_nn = (k_nn == 2) ? 0 : k_nn + 1;
        v_cur = (v_cur + 1) & 3; v_nn = (v_nn + 1) & 3;
    }
#undef DIFF_DMA
    if (active) {
        int td = tid, qr = qrow; asm volatile("" : "+v"(td), "+v"(qr));
        const float lam = lamp[0], oml = lamp[1];
        const float inv = __builtin_amdgcn_rcpf(swapsum(l)) * lam;
        const float* sp = stash + ((size_t)blockIdx.x * 512 + (td & ~63)) * 64 + (td & 63) * 4;
        float ss = 0.f;
#pragma unroll
        for (int cc = 0; cc < 4; ++cc)
#pragma unroll
            for (int g4 = 0; g4 < 4; ++g4) {
                const f32x4 sv = *(const f32x4*)(sp + (cc * 4 + g4) * 256);
#pragma unroll
                for (int e = 0; e < 4; ++e) { const float v = sv[e] - o[cc][4 * g4 + e] * inv; o[cc][4 * g4 + e] = v; ss += v * v; }
                if (g4 == 3) __builtin_amdgcn_sched_barrier(0);
            }
        ss = swapsum(ss);
        const float rstd = __builtin_amdgcn_rsqf(ss * (1.0f / 128.0f) + EPS) * oml;
        if (rowvalid) {
            const bf16_t* gp = proj + (size_t)(brow0 + qr) * NIN + C_BG + hh * 128;
            bf16_t* op = aout + (size_t)(brow0 + qr) * DM + 512 + hh * 128;
#pragma unroll
            for (int cc = 0; cc < 4; ++cc)
#pragma unroll
                for (int g4 = 0; g4 < 4; ++g4) {
                    const int d = 32 * cc + 8 * g4 + 4 * h;
                    const u32x2 gt = *(const u32x2*)(gp + d);
                    const f32x4 sg = *(const f32x4*)(subg + d);
                    const float v0 = o[cc][4 * g4 + 0] * rstd * sg[0] * silu(bf_lo(gt.x));
                    const float v1 = o[cc][4 * g4 + 1] * rstd * sg[1] * silu(bf_hi(gt.x));
                    const float v2 = o[cc][4 * g4 + 2] * rstd * sg[2] * silu(bf_lo(gt.y));
                    const float v3 = o[cc][4 * g4 + 3] * rstd * sg[3] * silu(bf_hi(gt.y));
                    u32x2 ov; ov.x = cvtpk(v0, v1); ov.y = cvtpk(v2, v3);
                    *(u32x2*)(op + d) = ov;
                    if (g4 & 1) __builtin_amdgcn_sched_barrier(0);
                }
        }
    }
}

constexpr int WK = 0, WV = 49152;
enum { M_NONE = 0, M_META = 1, M_BAND = 2, M_METAQ = 3 };
__device__ __forceinline__ void wait_vm(int n) {
    switch (n) {
        case 0: asm volatile("s_waitcnt vmcnt(0)" ::: "memory"); break;
        case 2: asm volatile("s_waitcnt vmcnt(2)" ::: "memory"); break;
        case 4: asm volatile("s_waitcnt vmcnt(4)" ::: "memory"); break;
        case 6: asm volatile("s_waitcnt vmcnt(6)" ::: "memory"); break;
        case 8: asm volatile("s_waitcnt vmcnt(8)" ::: "memory"); break;
        default: asm volatile("s_waitcnt vmcnt(10)" ::: "memory"); break;
    }
}
__device__ __forceinline__ void tile_win(f32x16 (&o)[2], float& m, float& l, f32x16& negm, const bf16x8 (&qf)[4], lcp kb, int kx, lcp vl, int vB0, int q1, int r0, int h, int S, int qi, int kind, bool first) {
    f32x16 s0, s1;
    bf16x8 kf[4][2];
#pragma unroll
    for (int ks = 0; ks < 4; ++ks) { kf[ks][0] = *(LAS const bf16x8*)(kb + (kx ^ (ks << 5))); kf[ks][1] = *(LAS const bf16x8*)(kb + (kx ^ (ks << 5)) + 4096); }
    __builtin_amdgcn_sched_barrier(0);
#pragma unroll
    for (int ks = 0; ks < 4; ++ks) {
        if (ks == 0) { s0 = __builtin_amdgcn_mfma_f32_32x32x16_bf16(kf[0][0], qf[0], negm, 0, 0, 0); s1 = __builtin_amdgcn_mfma_f32_32x32x16_bf16(kf[0][1], qf[0], negm, 0, 0, 0); }
        else { s0 = __builtin_amdgcn_mfma_f32_32x32x16_bf16(kf[ks][0], qf[ks], s0, 0, 0, 0); s1 = __builtin_amdgcn_mfma_f32_32x32x16_bf16(kf[ks][1], qf[ks], s1, 0, 0, 0); }
    }
    if (kind != M_NONE) {
        int hb = 4 * h + r0; asm volatile("" : "+v"(hb));
        if (kind == M_META) {
#pragma unroll
            for (int i = 0; i < 16; ++i) { const int kr = hb + (i & 3) + 8 * (i >> 2); s0[i] = kvalid<K_META>(kr, S, qi) ? s0[i] : NEG; s1[i] = kvalid<K_META>(kr + 32, S, qi) ? s1[i] : NEG; }
        } else if (kind == M_BAND) {
#pragma unroll
            for (int i = 0; i < 16; ++i) { const int kr = hb + (i & 3) + 8 * (i >> 2); s0[i] = kvalid<K_BAND>(kr, S, qi) ? s0[i] : NEG; s1[i] = kvalid<K_BAND>(kr + 32, S, qi) ? s1[i] : NEG; }
        } else {
#pragma unroll
            for (int i = 0; i < 16; ++i) { const int kr = hb + (i & 3) + 8 * (i >> 2); s0[i] = kvalid<K_METAQ>(kr, S, qi) ? s0[i] : NEG; s1[i] = kvalid<K_METAQ>(kr + 32, S, qi) ? s1[i] : NEG; }
        }
    }
    asm volatile("s_nop 15" : "+v"(s0), "+v"(s1));
    float mxa = max3f(s0[0], s0[1], s1[0]), mxb = max3f(s0[2], s0[3], s1[1]);
    mxa = max3f(mxa, s1[2], s1[3]);
#pragma unroll
    for (int i = 4; i < 16; i += 4) { mxa = max3f(mxa, s0[i], s0[i + 1]); mxb = max3f(mxb, s0[i + 2], s0[i + 3]); mxa = max3f(mxa, s1[i], s1[i + 1]); mxb = max3f(mxb, s1[i + 2], s1[i + 3]); }
    float mx = max3f(mxa, mxb, mxb);
    mx = swapmax(mx);
    if (first || __builtin_amdgcn_ballot_w64(mx > 8.0f) != 0ull) {
        const float delta = first ? mx : fmaxf(mx, 0.f);
        const float alpha = first ? 1.0f : ex2(-delta);
        m += delta; l *= alpha;
#pragma unroll
        for (int c = 0; c < 2; ++c)
#pragma unroll
            for (int i = 0; i < 16; ++i) asm volatile("v_mul_f32 %0, %1, %0" : "+v"(o[c][i]) : "v"(alpha));
#pragma unroll
        for (int i = 0; i < 16; ++i) { s0[i] -= delta; s1[i] -= delta; negm[i] = -m; }
    }
    const lcp vb0[2] = {vl + vB0 + ((0 ^ q1) << 6), vl + vB0 + ((1 ^ q1) << 6)};
    s16x4 alo[2][2], ahi[2][2];
#define VLOAD(kk, b) do { _Pragma("unroll") for (int c = 0; c < 2; ++c) { alo[b][c] = vtr(vb0[c] + 2048 * (kk)); ahi[b][c] = vtr(vb0[c] + 2048 * (kk) + 1024); } } while (0)
#define PVMMA(b, P) do { _Pragma("unroll") for (int c = 0; c < 2; ++c) { const s16x4 lo = alo[b][c], hi = ahi[b][c]; const bf16x8 a = {lo[0], lo[1], lo[2], lo[3], hi[0], hi[1], hi[2], hi[3]}; \
            o[c] = __builtin_amdgcn_mfma_f32_32x32x16_bf16(a, (P), o[c], 0, 0, 0); } } while (0)
#define EXP8(S_, b0) do { _Pragma("unroll") for (int i = (b0); i < (b0) + 8; ++i) { S_[i] = ex2(S_[i]); rs += S_[i]; } } while (0)
    float rs = 0.f;
    VLOAD(0, 0);
    EXP8(s0, 0); const bf16x8 p0 = pack8(s0, 0);
    __builtin_amdgcn_sched_barrier(0);
    VLOAD(1, 1); PVMMA(0, p0);
    EXP8(s0, 8); const bf16x8 p1 = pack8(s0, 8);
    __builtin_amdgcn_sched_barrier(0);
    VLOAD(2, 0); PVMMA(1, p1);
    EXP8(s1, 0); const bf16x8 p2 = pack8(s1, 0);
    __builtin_amdgcn_sched_barrier(0);
    VLOAD(3, 1); PVMMA(0, p2);
    EXP8(s1, 8); const bf16x8 p3 = pack8(s1, 8);
    __builtin_amdgcn_sched_barrier(0);
    PVMMA(1, p3);
    l += rs;
    __builtin_amdgcn_sched_barrier(0);
#undef VLOAD
#undef PVMMA
#undef EXP8
}
__device__ __forceinline__ void win_unit(LAS unsigned char* lds, const bf16_t* __restrict__ proj, bf16_t* __restrict__ aout,
                                         int g, int b, int kh, int qb, const float* __restrict__ sink) {
    int tid_ = threadIdx.x; asm volatile("" : "+v"(tid_));
    const int tid = tid_, lane = tid & 63, r32 = lane & 31, h = lane >> 5;
    const int w = __builtin_amdgcn_readfirstlane(tid >> 6);
    const int L = g ? LS : LP, S = g ? SS : SP, brow0 = g ? ROWS_P + b * LS : b * LP;
    const bool real = qb >= 0;
    const bool active = real || (w < 2);
    const int ntile = real ? 6 : 3;
    const int hq = real ? 4 * kh + (w & 3) : 4 * kh + 2 * (w & 1) + (r32 >> 4);
    const int qi = real ? 64 * qb + 32 * (w >> 2) + r32 : (r32 & 15);
    const int qrow = real ? 16 + qi : qi;
    const int band0 = 16 + 64 * qb - 128;
    const int kkey = 8 * w + (lane >> 3), kchunk = (lane & 7) ^ ((kkey >> 1) & 7), vchunk = (lane & 7) ^ (((kkey >> 1) & 1) << 2);
    const bf16_t* kbase = proj + (size_t)brow0 * NIN + C_AK + kh * 64 + kchunk * 8;
    const bf16_t* vbase = proj + (size_t)brow0 * NIN + C_AV + kh * 64 + vchunk * 8;
    const int fsw = (r32 >> 1) & 7;
    const lcp kb = (lcp)lds + WK + r32 * 128 + ((h ^ (fsw & 1)) * 16);
    const int kx = (fsw >> 1) << 5;
    const int q4 = (lane & 15) >> 2, blk = (lane >> 4) & 1, p4 = lane & 3;
    const int vB0 = (4 * h + q4) * 128 + (2 * blk + (p4 >> 1)) * 16 + 8 * (p4 & 1);
    const unsigned lds0 = (unsigned)(size_t)lds;

    f32x16 o[2]; float m = 0.f, l = 0.f; bf16x8 qf[4]; f32x16 negm;
#pragma unroll
    for (int i = 0; i < 16; ++i) { o[0][i] = 0.f; o[1][i] = 0.f; negm[i] = 0.f; }
    {
        const bf16_t* qptr = proj + (size_t)(brow0 + qrow) * NIN + C_AQ + hq * 64 + h * 8;
#pragma unroll
        for (int ks = 0; ks < 4; ++ks) qf[ks] = *(const bf16x8*)(qptr + ks * 16);
        asm volatile("" : "+v"(qf[0]), "+v"(qf[1]), "+v"(qf[2]), "+v"(qf[3]) :: "memory");
    }
#define WIN_R0(t) (real ? ((t) == 0 ? 0 : band0 + 64 * ((t) - 1)) : 64 * (t))
    for (int t = 0; t < ntile; ++t) {
        const size_t ro = (size_t)clampi(WIN_R0(t) + kkey, 0, L - 1) * NIN;
        glds16(kbase + ro, (unsigned)__builtin_amdgcn_readfirstlane(lds0 + WK + t * 8192 + w * 1024));
        glds16(vbase + ro, (unsigned)__builtin_amdgcn_readfirstlane(lds0 + WV + t * 8192 + w * 1024));
    }
    for (int t = 0; t < ntile; ++t) {
        wait_vm(2 * (ntile - 1 - t));
        __builtin_amdgcn_s_barrier(); asm volatile("" ::: "memory");
        if (active) {
            const int r0 = WIN_R0(t);
            int kind;
            if (!real) kind = M_METAQ;
            else if (t == 0) kind = M_META;
            else {
                const int u0 = r0 - 16, q0 = 64 * qb;
                kind = (u0 >= 0 && u0 + 63 < S && u0 + 63 - q0 <= 128 && q0 + 63 - u0 <= 128) ? M_NONE : M_BAND;
            }
            tile_win(o, m, l, negm, qf, kb + t * 8192, kx, (lcp)lds + WV + t * 8192, vB0, q4 >> 1, r0, h, S, qi, kind, t == 0);
        }
    }
#undef WIN_R0
    __builtin_amdgcn_s_barrier(); asm volatile("" ::: "memory");
    if (active) {
        int qr = qrow; asm volatile("" : "+v"(qr));
        const float lt = swapsum(l) + ex2(sink[hq] * LOG2E - m);
        const float inv = __builtin_amdgcn_rcpf(lt);
        const bf16_t* gp = proj + (size_t)(brow0 + qr) * NIN + C_AG + hq * 64;
        bf16_t* op = aout + (size_t)(brow0 + qr) * DM + hq * 64;
#pragma unroll
        for (int cc = 0; cc < 2; ++cc)
#pragma unroll
            for (int g4 = 0; g4 < 4; ++g4) {
                const int d = 32 * cc + 8 * g4 + 4 * h;
                const u32x2 gt = *(const u32x2*)(gp + d);
                const float v0 = o[cc][4 * g4 + 0] * inv * silu(bf_lo(gt.x));
                const float v1 = o[cc][4 * g4 + 1] * inv * silu(bf_hi(gt.x));
                const float v2 = o[cc][4 * g4 + 2] * inv * silu(bf_lo(gt.y));
                const float v3 = o[cc][4 * g4 + 3] * inv * silu(bf_hi(gt.y));
                u32x2 ov; ov.x = cvtpk(v0, v1); ov.y = cvtpk(v2, v3);
                *(u32x2*)(op + d) = ov;
            }
    }
}

__device__ __forceinline__ void attn_phase(LAS unsigned char* lds, const bf16_t* proj, bf16_t* aout, float* stash, unsigned* ctr, bool last,
                                           const float* lamp, const float* subg, const float* sink) {
    const int nP = last ? 16 : 17, nS = last ? 8 : 9;
    const int e1 = 8 * nP, e2 = e1 + 8 * nS, e3 = e2 + 256, e4 = e3 + 128, e5 = e4 + (last ? 0 : 8);
    LAS volatile int* su = (LAS volatile int*)(lds + OFF_UNIT);
    const int xcd = (int)(__builtin_amdgcn_s_getreg((3 << 11) | 20) & 7u);
    int kq = 0;
    for (;;) {
        if (threadIdx.x == 0) {
            int u = -1, x = 0;
            while (kq < 8) {
                x = (xcd + kq) & 7;
                int z; asm volatile("v_mov_b32 %0, 0" : "=v"(z));
                const int v = (int)__hip_atomic_fetch_add(ctr + 16 * x + z, 1u, __ATOMIC_RELAXED, __HIP_MEMORY_SCOPE_AGENT);
                if (v < e5) { u = v; break; }
                ++kq;
            }
            su[0] = u; su[1] = x;
        }
        __syncthreads();
        const int u = su[0], x = su[1];
        __syncthreads();
        if (u < 0) break;
        if (u < e2) {
            int g, bh, qb;
            if (u < e1) { const int j = u / nP, r = u - j * nP; g = 0; bh = x + 8 * j; qb = r < 16 ? r : -1; }
            else { const int v = u - e1, j = v / nS, r = v - j * nS; g = 1; bh = x + 8 * j; qb = r < 8 ? r : -1; }
            diff_unit(lds, proj, aout, stash, g, bh >> 2, bh & 3, qb, lamp, subg);
        } else {
            int g, bk, qb;
            if (u < e3) { const int v = u - e2; g = 0; bk = x + 8 * (v >> 6); qb = v & 63; }
            else if (u < e4) { const int v = u - e3; g = 1; bk = x + 8 * (v >> 5); qb = v & 31; }
            else { const int v = u - e4; g = v >> 2; bk = x + 8 * (v & 3); qb = -1; }
            win_unit(lds, proj, aout, g, bk >> 1, bk & 1, qb, sink);
        }
    }
}
}

constexpr int NWAVES = 8;
constexpr int LDS_BYTES = 147456;
constexpr int N_PHASES = 1 + 4 * DEPTH;

__device__ __forceinline__ void grid_bar(unsigned* cnt, unsigned target) {
    asm volatile("s_waitcnt vmcnt(0)" ::: "memory");
    __syncthreads();
    if (threadIdx.x == 0) {
        __builtin_amdgcn_fence(__ATOMIC_RELEASE, "agent");
        asm volatile("s_waitcnt vmcnt(0)" ::: "memory");
        int z; asm volatile("v_mov_b32 %0, 0" : "=v"(z));
        __hip_atomic_fetch_add(cnt + z, 1u, __ATOMIC_RELAXED, __HIP_MEMORY_SCOPE_AGENT);
        while (__hip_atomic_load(cnt, __ATOMIC_RELAXED, __HIP_MEMORY_SCOPE_AGENT) < target) __builtin_amdgcn_s_sleep(2);
        __builtin_amdgcn_fence(__ATOMIC_ACQUIRE, "agent");
        asm volatile("s_waitcnt vmcnt(0)" ::: "memory");
    }
    __syncthreads();
}

struct Args { const float* in[13]; float* out; unsigned char* ws; int ph_lo, ph_hi; };

__device__ __forceinline__ int src_col(int n) {
    const bool r = (n < C_AV) || (n >= C_BQ && n < C_BV);
    if (!r) return n;
    const int w = n & 63;
    return (n & ~63) + (w >> 1) + 32 * (w & 1);
}
__device__ __forceinline__ void transpose_item(const float* __restrict__ W, int N, bf16_t* __restrict__ WT, LAS float* scr, int item, int lane, bool permute) {
    const int nblk = N / 32, kb = item / nblk, nb = item % nblk, k0 = 64 * kb, n0 = 32 * nb;
    const int sc = permute ? src_col(n0 + (lane & 31)) : n0 + (lane & 31);
#pragma unroll 8
    for (int i = 0; i < 32; ++i) { const int kk = 2 * i + (lane >> 5); scr[kk * 33 + (lane & 31)] = W[(size_t)(k0 + kk) * N + sc]; }
    asm volatile("s_waitcnt lgkmcnt(0)" ::: "memory");
    const int c = lane & 7;
#pragma unroll
    for (int j = 0; j < 4; ++j) {
        const int n = (lane >> 3) + 8 * j; const LAS float* s = scr + (8 * c) * 33 + n;
        const int nn = n0 + n; const float sc = (permute && (nn < C_AK || (nn >= C_BQ && nn < C_BK))) ? 0.125f * 1.4426950408889634f : 1.0f;
        u32x4 o; o.x = cvtpk(s[0 * 33] * sc, s[1 * 33] * sc); o.y = cvtpk(s[2 * 33] * sc, s[3 * 33] * sc); o.z = cvtpk(s[4 * 33] * sc, s[5 * 33] * sc); o.w = cvtpk(s[6 * 33] * sc, s[7 * 33] * sc);
        *(u32x4*)(WT + (size_t)nn * 1024 + k0 + 8 * c) = o;
    }
    asm volatile("s_waitcnt lgkmcnt(0)" ::: "memory");
}

__device__ __forceinline__ const float* h0_row(const Args& a, int g, int b, int pos) {
    if (pos < 16) return a.in[2] + (size_t)pos * DM;
    return (g ? a.in[1] : a.in[0]) + ((size_t)b * (g ? SS : SP) + (pos - 16)) * DM;
}

__device__ __forceinline__ void prologue(const Args& a, LAS unsigned char* lds) {
    int tid_ = threadIdx.x; asm volatile("" : "+v"(tid_));
    const int tid = tid_, lane = tid & 63, wave = tid >> 6;
    const int gw = blockIdx.x * NWAVES + wave, NGW = gridDim.x * NWAVES;
    unsigned char* ws = a.ws;
    LAS float* scr = (LAS float*)(lds + wave * 16384);
    constexpr int I_IN = 16 * (NIN / 32), I_OUT = 16 * (DM / 32);
    constexpr int NITEMS = DEPTH * (I_IN + I_OUT);
    for (int it = gw; it < NITEMS; it += NGW) {
        if (it < DEPTH * I_IN) { const int l = it / I_IN, r = it - l * I_IN;
            transpose_item(a.in[3] + (size_t)l * DM * NIN, NIN, (bf16_t*)(ws + WS_WIN) + (size_t)l * NIN * DM, scr, r, lane, true); }
        else { const int q = it - DEPTH * I_IN, l = q / I_OUT, r = q - l * I_OUT;
            transpose_item(a.in[4] + (size_t)l * DM * DM, DM, (bf16_t*)(ws + WS_WOUT) + (size_t)l * DM * DM, scr, r, lane, false); }
    }
    {
        f32x2* rope = (f32x2*)(ws + WS_ROPE);
        for (int e = blockIdx.x * 512 + tid; e < LP * 32; e += gridDim.x * 512) {
            const int pos = e >> 5, i = e & 31;
            const float inv_freq = __builtin_amdgcn_exp2f(-(float)i * (13.287712379549449f / 32.0f));
            const float ang = (float)pos * inv_freq;
            const float rev = ang * 0.15915494309189535f;
            const float fr = rev - floorf(rev);
            f32x2 cs; cs.x = __builtin_amdgcn_cosf(fr); cs.y = __builtin_amdgcn_sinf(fr);
            rope[e] = cs;
        }
    }
    {
        const float* pg = a.in[5];
        bf16_t* hn = (bf16_t*)(ws + WS_HN);
        for (int row0 = gw; row0 < MROWS; row0 += 2 * NGW) {
            f32x4 v[2][4]; bool live[2]; int rows[2];
#pragma unroll
            for (int u = 0; u < 2; ++u) {
                const int row = row0 + u * NGW; live[u] = row < MROWS; rows[u] = live[u] ? row : MROWS - 1;
                int g, b, pos; row_decode(rows[u], g, b, pos);
                const float* x = h0_row(a, g, b, pos);
#pragma unroll
                for (int j = 0; j < 2; ++j) { v[u][2 * j] = *(const f32x4*)(x + 512 * j + lane * 8); v[u][2 * j + 1] = *(const f32x4*)(x + 512 * j + lane * 8 + 4); }
            }
#pragma unroll
            for (int u = 0; u < 2; ++u) {
                if (!live[u]) continue;
                float ss = 0.f;
#pragma unroll
                for (int j = 0; j < 4; ++j) ss += (v[u][j][0] * v[u][j][0] + v[u][j][1] * v[u][j][1]) + (v[u][j][2] * v[u][j][2] + v[u][j][3] * v[u][j][3]);
                const float rstd = __builtin_amdgcn_rsqf(wave_sum(ss, lane) * (1.0f / DM) + EPS);
#pragma unroll
                for (int j = 0; j < 2; ++j) {
                    const f32x4 g0 = *(const f32x4*)(pg + 512 * j + lane * 8), g1 = *(const f32x4*)(pg + 512 * j + lane * 8 + 4);
                    const f32x4 a0 = v[u][2 * j] * rstd * g0, a1 = v[u][2 * j + 1] * rstd * g1;
                    u32x4 o; o.x = cvtpk(a0[0], a0[1]); o.y = cvtpk(a0[2], a0[3]); o.z = cvtpk(a1[0], a1[1]); o.w = cvtpk(a1[2], a1[3]);
                    *(u32x4*)(hn + (size_t)rows[u] * DM + 512 * j + lane * 8) = o;
                }
            }
        }
    }
    {
        u32x4* pad = (u32x4*)(ws + WS_PROJ + (size_t)MROWS * NIN * 2);
        const u32x4 z = {0u, 0u, 0u, 0u};
        for (int e = blockIdx.x * 512 + tid; e < (64 * NIN * 2) / 16; e += gridDim.x * 512) pad[e] = z;
    }
    if (blockIdx.x == 0 && wave == 0) {
        float* lamv = (float*)(ws + WS_LAM);
        for (int l = 0; l < DEPTH; ++l) {
            const float s1 = wave_sum(a.in[8][l * 64 + lane] * a.in[9][l * 64 + lane], lane);
            const float s2 = wave_sum(a.in[10][l * 64 + lane] * a.in[11][l * 64 + lane], lane);
            const float li = 0.8f - 0.6f * expf(-0.3f * (float)l);
            if (lane == 0) { lamv[2 * l] = expf(s1) - expf(s2) + li; lamv[2 * l + 1] = 1.0f - li; }
        }
    }
}

struct NormRow { const float* hold; float* hnew; u32x4 r[2]; f32x4 ho[4]; bool live; bool meta; };
__device__ __forceinline__ void norm_load(const Args& a, int l, bool last, int row, int lane, const bf16_t* ob, float* metah, NormRow& R) {
    R.live = row < MROWS;
    const int rr = R.live ? row : MROWS - 1;
    int g, b, pos; row_decode(rr, g, b, pos);
    if (last && pos < 16) R.live = false;
    R.meta = pos < 16;
    if (pos < 16) { R.hnew = metah + ((size_t)(g * NB + b) * 16 + pos) * DM; R.hold = (l == 0) ? a.in[2] + (size_t)pos * DM : R.hnew; }
    else { const size_t off = (g ? (size_t)NB * SP * DM : 0) + ((size_t)b * (g ? SS : SP) + (pos - 16)) * DM; R.hnew = a.out + off;
           R.hold = (l == 0) ? (g ? a.in[1] : a.in[0]) + ((size_t)b * (g ? SS : SP) + (pos - 16)) * DM : R.hnew; }
#pragma unroll
    for (int j = 0; j < 2; ++j) R.r[j] = *(const u32x4*)(ob + (size_t)rr * DM + 512 * j + lane * 8);
    if (l == 0 || R.meta) {
#pragma unroll
        for (int j = 0; j < 4; ++j) R.ho[j] = *(const f32x4*)(R.hold + 512 * (j >> 1) + lane * 8 + 4 * (j & 1));
    } else {
        const bf16_t* hb = (const bf16_t*)R.hold;
#pragma unroll
        for (int j = 0; j < 2; ++j) {
            const u32x4 q = *(const u32x4*)(hb + 512 * j + lane * 8);
            R.ho[2 * j] = (f32x4){bf_lo(q.x), bf_hi(q.x), bf_lo(q.y), bf_hi(q.y)};
            R.ho[2 * j + 1] = (f32x4){bf_lo(q.z), bf_hi(q.z), bf_lo(q.w), bf_hi(q.w)};
        }
    }
}
__device__ __forceinline__ void norm_compute(const NormRow& R, int row, int lane, bool last, const f32x4 (&pgv)[4], const f32x4 (&prv)[4], bf16_t* hn) {
    if (!R.live) return;
    f32x4 ov[4]; float ss = 0.f;
#pragma unroll
    for (int j = 0; j < 2; ++j) {
        const u32x4 r = R.r[j];
        ov[2 * j] = (f32x4){bf_lo(r.x), bf_hi(r.x), bf_lo(r.y), bf_hi(r.y)};
        ov[2 * j + 1] = (f32x4){bf_lo(r.z), bf_hi(r.z), bf_lo(r.w), bf_hi(r.w)};
    }
#pragma unroll
    for (int j = 0; j < 4; ++j) ss += (ov[j][0] * ov[j][0] + ov[j][1] * ov[j][1]) + (ov[j][2] * ov[j][2] + ov[j][3] * ov[j][3]);
    const float rstd = __builtin_amdgcn_rsqf(wave_sum(ss, lane) * (1.0f / DM) + EPS);
    f32x4 hv[4]; float s2 = 0.f;
#pragma unroll
    for (int j = 0; j < 4; ++j) {
        const int c0 = 512 * (j >> 1) + lane * 8 + 4 * (j & 1);
        hv[j] = R.ho[j] + ov[j] * rstd * pgv[j];
        s2 += (hv[j][0] * hv[j][0] + hv[j][1] * hv[j][1]) + (hv[j][2] * hv[j][2] + hv[j][3] * hv[j][3]);
    }
    if (last || R.meta) {
#pragma unroll
        for (int j = 0; j < 4; ++j) { if (last) __builtin_nontemporal_store(hv[j], (f32x4*)(R.hnew + 512 * (j >> 1) + lane * 8 + 4 * (j & 1))); else *(f32x4*)(R.hnew + 512 * (j >> 1) + lane * 8 + 4 * (j & 1)) = hv[j]; }
    } else {
        bf16_t* hb = (bf16_t*)R.hnew;
#pragma unroll
        for (int j = 0; j < 2; ++j) {
            u32x4 o; o.x = cvtpk(hv[2 * j][0], hv[2 * j][1]); o.y = cvtpk(hv[2 * j][2], hv[2 * j][3]); o.z = cvtpk(hv[2 * j + 1][0], hv[2 * j + 1][1]); o.w = cvtpk(hv[2 * j + 1][2], hv[2 * j + 1][3]);
            __builtin_nontemporal_store(o, (u32x4*)(hb + 512 * j + lane * 8));
        }
    }
    if (!last) {
        const float rstd2 = __builtin_amdgcn_rsqf(wave_sum(s2, lane) * (1.0f / DM) + EPS);
#pragma unroll
        for (int j = 0; j < 2; ++j) {
            const int c0 = 512 * j + lane * 8;
            const f32x4 a0 = hv[2 * j] * rstd2 * prv[2 * j], a1 = hv[2 * j + 1] * rstd2 * prv[2 * j + 1];
            u32x4 o; o.x = cvtpk(a0[0], a0[1]); o.y = cvtpk(a0[2], a0[3]); o.z = cvtpk(a1[0], a1[1]); o.w = cvtpk(a1[2], a1[3]);
            *(u32x4*)(hn + (size_t)row * DM + c0) = o;
        }
    }
}
__device__ __forceinline__ void norm_phase(const Args& a, int l) {
    int tid_ = threadIdx.x; asm volatile("" : "+v"(tid_));
    const int tid = tid_, lane = tid & 63, wave = tid >> 6;
    const int gw = blockIdx.x * NWAVES + wave, NGW = gridDim.x * NWAVES;
    unsigned char* ws = a.ws;
    const bf16_t* ob = (const bf16_t*)(ws + WS_PROJ);
    bf16_t* hn = (bf16_t*)(ws + WS_HN);
    float* metah = (float*)(ws + WS_METAH);
    const float* postg = a.in[6] + (size_t)l * DM;
    const bool last = (l == DEPTH - 1);
    const float* preg = a.in[5] + (size_t)(last ? l : l + 1) * DM;
    f32x4 pgv[4], prv[4];
#pragma unroll
    for (int j = 0; j < 4; ++j) { const int c0 = 512 * (j >> 1) + lane * 8 + 4 * (j & 1); pgv[j] = *(const f32x4*)(postg + c0); prv[j] = *(const f32x4*)(preg + c0); }
    for (int row = gw; row < MROWS; row += 2 * NGW) {
        NormRow A, B;
        norm_load(a, l, last, row, lane, ob, metah, A);
        norm_load(a, l, last, row + NGW, lane, ob, metah, B);
        norm_compute(A, row, lane, last, pgv, prv, hn);
        norm_compute(B, row + NGW, lane, last, pgv, prv, hn);
    }
}

__global__ void __launch_bounds__(NWAVES * 64, 2) fwd_kernel(Args a) {
    extern __shared__ __attribute__((aligned(16))) unsigned char lds_raw[];
    LAS unsigned char* lds = (LAS unsigned char*)lds_raw;
    unsigned char* ws = a.ws;
#define IN(k) true
#define SEAM(k) do { ++nbar; grid_bar((unsigned*)(ws + WS_CTL) + 1024, nbar * gridDim.x); } while (0)
    unsigned nbar = 0;
    if (IN(0)) { prologue(a, lds); }
    cg::this_grid().sync();
    for (int l = 0; l < DEPTH; ++l) {
        const int p0 = 1 + 4 * l;
        if (IN(p0)) {
            pg8::Gemm g{(const bf16_t*)(ws + WS_HN), (const bf16_t*)(ws + WS_WIN) + (size_t)l * NIN * DM, MROWS, NIN, DM};
            pg8::StaticOrder S; S.init(MROWS, NIN, (int)gridDim.x, (int)blockIdx.x);
            pg8::EpiStore<true> E{(bf16_t*)(ws + WS_PROJ), NIN, (const f32x2*)(ws + WS_ROPE)};
            pg8::gemm_phase<pg8::EpiStore<true>, pg8::StaticOrder, true, true>(lds, g, S, E);
        }
        SEAM(p0);
        if (IN(p0 + 1)) {
            att::attn_phase(lds, (const bf16_t*)(ws + WS_PROJ), (bf16_t*)(ws + WS_HN), (float*)(ws + WS_STASH), (unsigned*)(ws + WS_CTL) + 2048 + 512 * l, l == DEPTH - 1,
                            (const float*)(ws + WS_LAM) + 2 * l, a.in[12] + (size_t)l * 128, a.in[7] + (size_t)l * 8);
        }
        SEAM(p0 + 1);
        if (IN(p0 + 2)) {
            pg8::Gemm g{(const bf16_t*)(ws + WS_HN), (const bf16_t*)(ws + WS_WOUT) + (size_t)l * DM * DM, MROWS, DM, DM};
            pg8::StaticOrder S; S.init(MROWS, DM, (int)gridDim.x, (int)blockIdx.x);
            pg8::EpiStore<false> E{(bf16_t*)(ws + WS_PROJ), DM, nullptr};
            pg8::gemm_phase<pg8::EpiStore<false>, pg8::StaticOrder, true, true>(lds, g, S, E);
        }
        SEAM(p0 + 2);
        if (IN(p0 + 3)) norm_phase(a, l);
        SEAM(p0 + 3);
    }
#undef IN
#undef SEAM
}

extern "C" void kernel_launch(void* const* d_in, const int* in_sizes, int n_in, void* d_out, int out_size, void* d_ws, size_t ws_size, hipStream_t stream) {
    static int grid = 0;
    if (grid == 0) {
        if (n_in != 13 || ws_size < WS_END) { fprintf(stderr, "kernel_launch: need 13 inputs and >= %zu bytes of workspace; got %d, %zu\n", (size_t)WS_END, n_in, ws_size); grid = -1; return; }
        int dev = 0, cus = 0, per_cu = 0;
        if (hipGetDevice(&dev) != hipSuccess || hipDeviceGetAttribute(&cus, hipDeviceAttributeMultiprocessorCount, dev) != hipSuccess) { grid = -1; return; }
        if (hipFuncSetAttribute((const void*)fwd_kernel, hipFuncAttributeMaxDynamicSharedMemorySize, LDS_BYTES) != hipSuccess) { fprintf(stderr, "kernel_launch: hipFuncSetAttribute failed\n"); grid = -1; return; }
        if (hipOccupancyMaxActiveBlocksPerMultiprocessor(&per_cu, (const void*)fwd_kernel, NWAVES * 64, LDS_BYTES) != hipSuccess || per_cu < 1) { fprintf(stderr, "kernel_launch: occupancy query says %d\n", per_cu); per_cu = 1; }
        (void)hipGetLastError();
        grid = cus * 1;
    }
    if (grid < 0) return;
    (void)hipMemsetAsync((char*)d_ws + WS_CTL, 0, CTL_BYTES, stream);
    Args a{};
    for (int i = 0; i < 13; ++i) a.in[i] = (const float*)d_in[i];
    a.out = (float*)d_out; a.ws = (unsigned char*)d_ws; a.ph_lo = 0; a.ph_hi = N_PHASES;
    void* args[] = {&a};
    hipError_t e = hipLaunchCooperativeKernel((const void*)fwd_kernel, dim3(grid), dim3(NWAVES * 64), args, LDS_BYTES, stream);
    if (e != hipSuccess) fprintf(stderr, "cooperative launch failed: %s (grid %d)\n", hipGetErrorString(e), grid);
}
```

```cpp
#include <hip/hip_runtime.h>
#include <hip/hip_cooperative_groups.h>
#include <cstdio>
#include <cstdint>
namespace cg = cooperative_groups;

constexpr int DM = 1024, NIN = 3328, NB = 16, DEPTH = 4;
constexpr int LP = 4112, LS = 2064, SP = 4096, SS = 2048;
constexpr int ROWS_P = NB * LP, ROWS_S = NB * LS, MROWS = ROWS_P + ROWS_S;
constexpr float EPS = 1e-6f;
constexpr int C_AQ = 0, C_AK = 512, C_AV = 640, C_AG = 768, C_BQ = 1280, C_BK = 1792, C_BV = 2304, C_BG = 2816;

constexpr size_t MiB = 1u << 20;
constexpr size_t WS_CTL = 0, CTL_BYTES = 65536;
constexpr size_t WS_LAM = 1 * MiB;
constexpr size_t WS_ROPE = 2 * MiB;
constexpr size_t WS_WIN = 4 * MiB;
constexpr size_t WS_WOUT = 30 * MiB;
constexpr size_t WS_METAH = 38 * MiB;
constexpr size_t WS_STASH = 40 * MiB;
constexpr size_t WS_HN = 72 * MiB;
constexpr size_t WS_PROJ = 266 * MiB;
constexpr size_t WS_END = 894 * MiB;

#define LAS __attribute__((address_space(3)))
typedef unsigned short bf16_t;
typedef short bf16x8 __attribute__((ext_vector_type(8)));
typedef short s16x4 __attribute__((ext_vector_type(4)));
typedef float f32x2 __attribute__((ext_vector_type(2)));
typedef float f32x4 __attribute__((ext_vector_type(4)));
typedef float f32x16 __attribute__((ext_vector_type(16)));
typedef unsigned u32x2 __attribute__((ext_vector_type(2)));
typedef unsigned u32x4 __attribute__((ext_vector_type(4)));

__device__ __forceinline__ unsigned cvtpk(float lo, float hi) {
    typedef __bf16 b2 __attribute__((ext_vector_type(2)));
    f32x2 v = {lo, hi}; b2 b = __builtin_convertvector(v, b2); return __builtin_bit_cast(unsigned, b);
}
__device__ __forceinline__ float bf_lo(unsigned u) { return __uint_as_float(u << 16); }
__device__ __forceinline__ float bf_hi(unsigned u) { return __uint_as_float(u & 0xffff0000u); }
__device__ __forceinline__ float wave_sum(float v, int lane) {
#pragma unroll
    for (int o = 1; o < 64; o <<= 1) v += __int_as_float(__builtin_amdgcn_ds_bpermute((lane ^ o) << 2, __float_as_int(v)));
    return v;
}
__device__ __forceinline__ void row_decode(int row, int& g, int& b, int& pos) {
    if (row < ROWS_P) { g = 0; b = row / LP; pos = row - b * LP; }
    else { const int r = row - ROWS_P; g = 1; b = r / LS; pos = r - b * LS; }
}

namespace pg8 {
#define PG8_LAS __attribute__((address_space(3)))
constexpr int BM = 256, BK = 64, HALF = 128, HTB = HALF * BK * 2  , STAGE_BYTES = 8 * HTB, NXCD = 8, WGM = 8;

__host__ __device__ __forceinline__ int lds_byte(int r, int c) { const int st = (r >> 4) * 2 + (c >> 5), rr = r & 15, cc = c & 31, ob = rr * 64 + cc * 2; return st * 1024 + (ob ^ (((ob >> 9) & 1) << 5)); }
__host__ __device__ __forceinline__ void stage_rc(int b, int& R, int& C) { const int st = b / 1024, sb = b % 1024, swz = sb ^ (((sb >> 9) & 1) << 5); R = (st >> 1) * 16 + swz / 64; C = (st & 1) * 32 + (swz % 64) / 2; }
__host__ __device__ __forceinline__ int perm32(int rho) { const int n = rho >> 4, i = rho & 15; return 8 * (i >> 2) + 4 * n + (i & 3); }

struct Unit { int pm, pn; };
struct Gemm { const bf16_t* A; const bf16_t* Bt; int M, N, K; };

struct StaticOrder {
    int nM, nN, nwg, G, c;
    __host__ __device__ void init(int M, int N, int G_, int c_) { nM = M / BM; nN = N / BM; nwg = nM * nN; G = G_; c = c_; }
    __host__ __device__ bool next(int i, Unit& u) const {
        const long L = (long)i * G + c; if (L >= nwg) return false;
        int wgid = (int)L; { const int q = nwg / NXCD, r = nwg % NXCD, xcd = wgid % NXCD, off = wgid / NXCD; wgid = (xcd < r ? xcd * (q + 1) : r * (q + 1) + (xcd - r) * q) + off; }
        const int nig = WGM * nN, gid = wgid / nig, fm = gid * WGM, gsz = (nM - fm) < WGM ? (nM - fm) : WGM;
        u.pm = fm + ((wgid % nig) % gsz); u.pn = (wgid % nig) / gsz; return true;
    }
    __device__ __forceinline__ void a_ready(const Unit&) const {}
    __device__ __forceinline__ void done(const Unit&) const {}
};

template <bool ROPE> struct EpiStore {
    static constexpr bool PERM = true, AFTER_DRAIN = false;
    bf16_t* O; int ldc; const f32x2* rope;
    __device__ __forceinline__ void operator()(const f32x4 (&acc)[2][2][4][2], const Unit& u, int wr, int wc, int fr, int fq) const {
        const int row0 = u.pm * BM + wr * 64 + fr; const int col0 = u.pn * BM + wc * 32 + 8 * fq;
#pragma unroll
        for (int ai = 0; ai < 2; ++ai)
#pragma unroll
            for (int m = 0; m < 4; ++m) {
                const int row = row0 + ai * HALF + m * 16;
                bf16_t* rowp = O + (size_t)row * ldc + col0;
                int pos = 0;
                if (ROPE) { int g, b; row_decode(row, g, b, pos); }
#pragma unroll
                for (int bj = 0; bj < 2; ++bj) {
                    f32x4 v0 = acc[ai][bj][m][0], v1 = acc[ai][bj][m][1];
                    if (ROPE) {
                        const int half = 2 * u.pn + bj;
                        const bool dorope = (half < 5) || (half >= 10 && half < 18);
                        if (dorope) {
                            const int i0 = ((col0 + bj * HALF) & 63) >> 1;
                            const f32x4* rp = (const f32x4*)(rope + (size_t)pos * 32 + i0);
                            const f32x4 cs0 = rp[0], cs1 = rp[1];
                            f32x4 w0, w1;
                            w0[0] = (v0[0] * cs0[0] - v0[1] * cs0[1]); w0[1] = (v0[1] * cs0[0] + v0[0] * cs0[1]);
                            w0[2] = (v0[2] * cs0[2] - v0[3] * cs0[3]); w0[3] = (v0[3] * cs0[2] + v0[2] * cs0[3]);
                            w1[0] = (v1[0] * cs1[0] - v1[1] * cs1[1]); w1[1] = (v1[1] * cs1[0] + v1[0] * cs1[1]);
                            w1[2] = (v1[2] * cs1[2] - v1[3] * cs1[3]); w1[3] = (v1[3] * cs1[2] + v1[2] * cs1[3]);
                            v0 = w0; v1 = w1;
                        }
                    }
                    u32x4 w; w.x = cvtpk(v0[0], v0[1]); w.y = cvtpk(v0[2], v0[3]); w.z = cvtpk(v1[0], v1[1]); w.w = cvtpk(v1[2], v1[3]);
                    *(u32x4*)(rowp + bj * HALF) = w;
                }
            }
    }
};

template <class Epi, class Sched, bool ALIGN_EPI = false, bool SP2 = false>
__device__ __forceinline__ void gemm_phase(PG8_LAS unsigned char* lds, const Gemm g, const Sched& S, const Epi& E) {
    int tid_ = threadIdx.x; asm volatile("" : "+v"(tid_));
    const int tid = tid_, wid = __builtin_amdgcn_readfirstlane(tid >> 6), lane = tid & 63, wr = wid >> 2, wc = wid & 3, fr = lane & 15, fq = lane >> 4;
    const int K = g.K, nt = K / BK;
    unsigned voffA[2], voffB[2];
#pragma unroll
    for (int i = 0; i < 2; ++i) { int R, C; stage_rc(tid * 16 + i * 8192, R, C); const int Rb = Epi::PERM ? ((R & ~31) + perm32(R & 31)) : R;
        voffA[i] = (unsigned)(R * K + C) * 2u; voffB[i] = (unsigned)(Rb * K + C) * 2u; }
    const size_t kstep = (size_t)(BK * 2);
    const size_t hstep = (size_t)HALF * K * 2;
    const size_t tstep = 2 * hstep;
    const unsigned ldsw = (unsigned)wid * 1024u;
    const int aoff = lds_byte(wr * 64 + fr, fq * 8), boff = lds_byte(wc * 32 + fr, fq * 8);
#define PG8_SA(b, h) (((b) * 2 + (h)) * HTB)
#define PG8_SB(b, h) ((4 + (b) * 2 + (h)) * HTB)
#define PG8_STAGE(bufoff, gbase, voff) do { _Pragma("unroll") for (int _i = 0; _i < 2; ++_i) \
        __builtin_amdgcn_global_load_lds((const unsigned*)((const char*)(gbase) + (voff)[_i]), (PG8_LAS unsigned*)(lds + (bufoff) + ldsw + _i * 8192), 16, 0, 0); } while (0)
#define PG8_LDA(dst, b, h) do { _Pragma("unroll") for (int m = 0; m < 4; ++m) _Pragma("unroll") for (int k = 0; k < 2; ++k) dst[m][k] = *(const PG8_LAS bf16x8*)(lds + PG8_SA(b, h) + aoff + m * 2048 + k * 1024); } while (0)
#define PG8_LDB(dst, b, h) do { _Pragma("unroll") for (int n = 0; n < 2; ++n) _Pragma("unroll") for (int k = 0; k < 2; ++k) dst[n][k] = *(const PG8_LAS bf16x8*)(lds + PG8_SB(b, h) + boff + n * 2048 + k * 1024); } while (0)
#define PG8_MMA(ai, bj, At, Bt) do { __builtin_amdgcn_s_setprio(1); _Pragma("unroll") for (int m = 0; m < 4; ++m) _Pragma("unroll") for (int n = 0; n < 2; ++n) _Pragma("unroll") for (int k = 0; k < 2; ++k) \
        acc[ai][bj][m][n] = __builtin_amdgcn_mfma_f32_16x16x32_bf16(Bt[n][k], At[m][k], acc[ai][bj][m][n], 0, 0, 0); __builtin_amdgcn_s_setprio(0); } while (0)
#define PG8_WAIT_V(n) asm volatile("s_waitcnt vmcnt(" #n ")" ::: "memory")
#define PG8_WAIT_L(n) asm volatile("s_waitcnt lgkmcnt(" #n ")" ::: "memory")
#define PG8_BAR __builtin_amdgcn_s_barrier()
#define PG8_SCHED __builtin_amdgcn_sched_barrier(0)
    Unit cur, nxt; int ui = 0;
    (void)S.next(0, cur);
    f32x4 acc[2][2][4][2];
#pragma unroll
    for (int a = 0; a < 2; ++a)
#pragma unroll
        for (int b = 0; b < 2; ++b)
#pragma unroll
            for (int m = 0; m < 4; ++m)
#pragma unroll
                for (int n = 0; n < 2; ++n) acc[a][b][m][n] = (f32x4){0.f, 0.f, 0.f, 0.f};
    bf16x8 At[4][2], B0[2][2], B1[2][2];
    const char* cA = (const char*)g.A + (size_t)cur.pm * tstep; const char* cB = (const char*)g.Bt + (size_t)cur.pn * tstep;
    S.a_ready(cur);
    if constexpr (SP2) {
        PG8_STAGE(PG8_SB(0, 0), cB, voffB); PG8_STAGE(PG8_SB(0, 1), cB + hstep, voffB); PG8_STAGE(PG8_SA(0, 0), cA, voffA); PG8_STAGE(PG8_SA(0, 1), cA + hstep, voffA);
        if (wr == 1) PG8_BAR;
        PG8_WAIT_V(2); PG8_BAR;
        PG8_STAGE(PG8_SB(1, 0), cB + kstep, voffB); PG8_STAGE(PG8_SA(1, 0), cA + kstep, voffA); PG8_STAGE(PG8_SB(1, 1), cB + hstep + kstep, voffB);
        PG8_WAIT_V(6); PG8_BAR;
    } else {
        PG8_STAGE(PG8_SB(0, 0), cB, voffB); PG8_STAGE(PG8_SA(0, 0), cA, voffA); PG8_STAGE(PG8_SB(0, 1), cB + hstep, voffB); PG8_STAGE(PG8_SA(0, 1), cA + hstep, voffA);
        if (wr == 1) PG8_BAR;
        PG8_WAIT_V(4); PG8_BAR;
        PG8_STAGE(PG8_SB(1, 0), cB + kstep, voffB); PG8_STAGE(PG8_SA(1, 0), cA + kstep, voffA); PG8_STAGE(PG8_SB(1, 1), cB + hstep + kstep, voffB);
        PG8_WAIT_V(6); PG8_BAR;
    }
    for (;;) {
        const bool has_next = S.next(ui + 1, nxt);
        const char* nA = has_next ? (const char*)g.A + (size_t)nxt.pm * tstep : cA; const char* nB = has_next ? (const char*)g.Bt + (size_t)nxt.pn * tstep : cB;
        for (int t = 0; t < nt; t += 2) {
            const bool last = (t == nt - 2);
            const char* a1 = cA + (size_t)(t + 1) * kstep;
            const char* a2 = last ? nA : cA + (size_t)(t + 2) * kstep; const char* b2 = last ? nB : cB + (size_t)(t + 2) * kstep;
            const char* a3 = a2 + kstep; const char* b3 = b2 + kstep;
            if (last && has_next) S.a_ready(nxt);
            if constexpr (SP2) {
            PG8_LDB(B0, 0, 0); PG8_LDB(B1, 0, 1); PG8_SCHED; PG8_LDA(At, 0, 0); PG8_STAGE(PG8_SA(1, 1), a1 + hstep, voffA);
            PG8_WAIT_V(8); PG8_WAIT_L(0); PG8_BAR; PG8_MMA(0, 0, At, B0); PG8_MMA(0, 1, At, B1); PG8_BAR; PG8_SCHED;
            PG8_LDA(At, 0, 1); PG8_STAGE(PG8_SB(0, 0), b2, voffB); PG8_STAGE(PG8_SB(0, 1), b2 + hstep, voffB); PG8_STAGE(PG8_SA(0, 0), a2, voffA);
            PG8_WAIT_V(8); PG8_WAIT_L(0); PG8_BAR; PG8_MMA(1, 0, At, B0); PG8_MMA(1, 1, At, B1); PG8_BAR; PG8_SCHED;
            PG8_LDB(B0, 1, 0); PG8_LDB(B1, 1, 1); PG8_SCHED; PG8_LDA(At, 1, 0); PG8_STAGE(PG8_SA(0, 1), a2 + hstep, voffA);
            PG8_WAIT_V(8); PG8_WAIT_L(0); PG8_BAR; PG8_MMA(0, 0, At, B0); PG8_MMA(0, 1, At, B1); PG8_BAR; PG8_SCHED;
            PG8_LDA(At, 1, 1); PG8_STAGE(PG8_SB(1, 0), b3, voffB); PG8_STAGE(PG8_SB(1, 1), b3 + hstep, voffB); PG8_STAGE(PG8_SA(1, 0), a3, voffA);
            PG8_WAIT_V(8); PG8_WAIT_L(0); PG8_BAR; PG8_MMA(1, 0, At, B0); PG8_MMA(1, 1, At, B1); PG8_BAR; PG8_SCHED;
            } else {
            PG8_LDB(B0, 0, 0); PG8_SCHED; PG8_LDA(At, 0, 0); PG8_STAGE(PG8_SA(1, 1), a1 + hstep, voffA);
            PG8_WAIT_L(8); PG8_BAR; PG8_WAIT_L(0); PG8_MMA(0, 0, At, B0); PG8_BAR; PG8_SCHED;
            PG8_LDB(B1, 0, 1); PG8_STAGE(PG8_SB(0, 0), b2, voffB);
            PG8_BAR; PG8_WAIT_L(0); PG8_MMA(0, 1, At, B1); PG8_BAR;
            PG8_LDA(At, 0, 1); PG8_STAGE(PG8_SA(0, 0), a2, voffA);
            PG8_BAR; PG8_WAIT_L(0); PG8_MMA(1, 0, At, B0); PG8_BAR; PG8_SCHED;
            PG8_STAGE(PG8_SB(0, 1), b2 + hstep, voffB);
            PG8_WAIT_V(6); PG8_BAR; PG8_MMA(1, 1, At, B1); PG8_BAR;
            PG8_LDB(B0, 1, 0); PG8_SCHED; PG8_LDA(At, 1, 0); PG8_STAGE(PG8_SA(0, 1), a2 + hstep, voffA);
            PG8_WAIT_L(8); PG8_BAR; PG8_WAIT_L(0); PG8_MMA(0, 0, At, B0); PG8_BAR; PG8_SCHED;
            PG8_LDB(B1, 1, 1); PG8_STAGE(PG8_SB(1, 0), b3, voffB);
            PG8_BAR; PG8_WAIT_L(0); PG8_MMA(0, 1, At, B1); PG8_BAR;
            PG8_LDA(At, 1, 1); PG8_STAGE(PG8_SA(1, 0), a3, voffA);
            PG8_BAR; PG8_WAIT_L(0); PG8_MMA(1, 0, At, B0); PG8_BAR; PG8_SCHED;
            PG8_STAGE(PG8_SB(1, 1), b3 + hstep, voffB);
            PG8_WAIT_V(6); PG8_BAR; PG8_MMA(1, 1, At, B1); PG8_BAR;
            }
        }
        if constexpr (ALIGN_EPI) { if (wr == 0) PG8_BAR; }
        if constexpr (!Epi::AFTER_DRAIN) { E(acc, cur, wr, wc, fr, fq); S.done(cur); }
        if (!has_next) break;
#pragma unroll
        for (int a = 0; a < 2; ++a)
#pragma unroll
            for (int b = 0; b < 2; ++b)
#pragma unroll
                for (int m = 0; m < 4; ++m)
#pragma unroll
                    for (int n = 0; n < 2; ++n) acc[a][b][m][n] = (f32x4){0.f, 0.f, 0.f, 0.f};
        cur = nxt; cA = nA; cB = nB; ++ui;
        if constexpr (ALIGN_EPI) { if (wr == 1) PG8_BAR; }
    }
    PG8_WAIT_V(0);
    if constexpr (!ALIGN_EPI) { if (wr == 0) PG8_BAR; }
    PG8_BAR;
    if constexpr (Epi::AFTER_DRAIN) { E.fused(acc, cur, wr, wc, fr, fq, lds, wid, lane); S.done(cur); }
#undef PG8_SA
#undef PG8_SB
#undef PG8_STAGE
#undef PG8_LDA
#undef PG8_LDB
#undef PG8_MMA
#undef PG8_WAIT_V
#undef PG8_WAIT_L
#undef PG8_BAR
#undef PG8_SCHED
}
}

namespace att {
typedef short v4i16_t __attribute__((ext_vector_type(4)));
typedef LAS const unsigned char* lcp;
constexpr float NEG = -1.0e30f;
constexpr float LOG2E = 1.4426950408889634f;
constexpr int KP = 144, VP128 = 320, VP64 = 192;
constexpr int KBUF = 64 * KP, VBUF = 64 * VP128;
constexpr int SW_K = 0, SW_V = 24576;
constexpr int OFF_K0 = 0, OFF_K1 = KBUF, OFF_V0 = 2 * KBUF, OFF_V1 = 2 * KBUF + VBUF, OFF_UNIT = 131072;
enum { K_NONE = 0, K_DENSE = 1, K_META = 2, K_BAND = 3, K_METAQ = 4 };

__device__ __forceinline__ int crow(int i, int h) { return (i & 3) + 8 * (i >> 2) + 4 * h; }
__device__ __forceinline__ float swapmax(float v) { auto rr = __builtin_amdgcn_permlane32_swap(__float_as_uint(v), __float_as_uint(v), false, false); return fmaxf(__uint_as_float(rr[0]), __uint_as_float(rr[1])); }
__device__ __forceinline__ float swapsum(float v) { auto rr = __builtin_amdgcn_permlane32_swap(__float_as_uint(v), __float_as_uint(v), false, false); return __uint_as_float(rr[0]) + __uint_as_float(rr[1]); }
__device__ __forceinline__ s16x4 vtr(lcp p) { return __builtin_bit_cast(s16x4, __builtin_amdgcn_ds_read_tr16_b64_v4i16((LAS v4i16_t*)p)); }
__device__ __forceinline__ float max3f(float a, float b, float c) { float r; asm("v_max3_f32 %0, %1, %2, %3" : "=v"(r) : "v"(a), "v"(b), "v"(c)); return r; }
__device__ __forceinline__ float ex2(float x) { return __builtin_amdgcn_exp2f(x); }
__device__ __forceinline__ float silu(float x) { return x * __builtin_amdgcn_rcpf(1.0f + ex2(-x * LOG2E)); }

template <int KIND> __device__ __forceinline__ bool kvalid(int kr, int lim, int qi) {
    if (KIND == K_DENSE) return kr < lim;
    if (KIND == K_META) return kr < 16;
    if (KIND == K_BAND) { const int u = kr - 16; const int d = u - qi; return (unsigned)u < (unsigned)lim && d <= 128 && d >= -128; }
    if (KIND == K_METAQ) { const int u = kr - 16; return kr < 16 || (u < 128 && u <= 112 + qi); }
    return true;
}

template <int DV, int KIND>
__device__ __forceinline__ void tile_compute(f32x16 (&o)[DV / 32], float& m, float& l, const bf16x8 (&qf)[4], lcp kb, lcp vb, int r0, int h, int lim, int qi) {
    constexpr int VP = (DV == 128) ? VP128 : VP64;
    f32x16 s0, s1;
#pragma unroll
    for (int i = 0; i < 16; ++i) { s0[i] = 0.f; s1[i] = 0.f; }
#pragma unroll
    for (int ks = 0; ks < 4; ++ks) {
        const bf16x8 k0 = *(LAS const bf16x8*)(kb + ks * 32);
        const bf16x8 k1 = *(LAS const bf16x8*)(kb + 32 * KP + ks * 32);
        s0 = __builtin_amdgcn_mfma_f32_32x32x16_bf16(k0, qf[ks], s0, 0, 0, 0);
        s1 = __builtin_amdgcn_mfma_f32_32x32x16_bf16(k1, qf[ks], s1, 0, 0, 0);
        if (ks == 1) __builtin_amdgcn_sched_barrier(0);
    }
    if (KIND != K_NONE) {
        int hb = 4 * h + r0; asm volatile("" : "+v"(hb));
#pragma unroll
        for (int i = 0; i < 16; ++i) {
            const int kr = hb + (i & 3) + 8 * (i >> 2);
            s0[i] = kvalid<KIND>(kr, lim, qi) ? s0[i] : NEG;
            s1[i] = kvalid<KIND>(kr + 32, lim, qi) ? s1[i] : NEG;
        }
    }
    float mx = fmaxf(s0[0], s1[0]);
#pragma unroll
    for (int i = 1; i < 16; ++i) mx = fmaxf(mx, fmaxf(s0[i], s1[i]));
    mx = swapmax(mx);
    const float mn = fmaxf(m, mx);
    const float alpha = ex2(m - mn);
    m = mn;
    float rs = 0.f;
#pragma unroll
    for (int i = 0; i < 16; ++i) { s0[i] = ex2(s0[i] - mn); s1[i] = ex2(s1[i] - mn); rs += s0[i] + s1[i]; }
    l = l * alpha + rs;
#pragma unroll
    for (int c = 0; c < DV / 32; ++c)
#pragma unroll
        for (int i = 0; i < 16; ++i) o[c][i] *= alpha;
    bf16x8 pf[4];
    {
        u32x4 w;
        w.x = cvtpk(s0[0], s0[1]); w.y = cvtpk(s0[2], s0[3]); w.z = cvtpk(s0[4], s0[5]); w.w = cvtpk(s0[6], s0[7]); pf[0] = __builtin_bit_cast(bf16x8, w);
        w.x = cvtpk(s0[8], s0[9]); w.y = cvtpk(s0[10], s0[11]); w.z = cvtpk(s0[12], s0[13]); w.w = cvtpk(s0[14], s0[15]); pf[1] = __builtin_bit_cast(bf16x8, w);
        w.x = cvtpk(s1[0], s1[1]); w.y = cvtpk(s1[2], s1[3]); w.z = cvtpk(s1[4], s1[5]); w.w = cvtpk(s1[6], s1[7]); pf[2] = __builtin_bit_cast(bf16x8, w);
        w.x = cvtpk(s1[8], s1[9]); w.y = cvtpk(s1[10], s1[11]); w.z = cvtpk(s1[12], s1[13]); w.w = cvtpk(s1[14], s1[15]); pf[3] = __builtin_bit_cast(bf16x8, w);
    }
    constexpr int NC = DV / 32;
#pragma unroll
    for (int kk = 0; kk < 4; ++kk) {
        s16x4 alo[NC], ahi[NC];
#pragma unroll
        for (int c = 0; c < NC; ++c) { alo[c] = vtr(vb + (16 * kk) * VP + c * 64); ahi[c] = vtr(vb + (16 * kk + 8) * VP + c * 64); }
#pragma unroll
        for (int c = 0; c < NC; ++c) {
            const s16x4 lo = alo[c], hi = ahi[c];
            const bf16x8 a = {lo[0], lo[1], lo[2], lo[3], hi[0], hi[1], hi[2], hi[3]};
            o[c] = __builtin_amdgcn_mfma_f32_32x32x16_bf16(a, pf[kk], o[c], 0, 0, 0);
        }
        __builtin_amdgcn_sched_barrier(0);
    }
}

__device__ __forceinline__ bf16x8 pack8(const f32x16& s, int b) {
    u32x4 w; w.x = cvtpk(s[b], s[b + 1]); w.y = cvtpk(s[b + 2], s[b + 3]); w.z = cvtpk(s[b + 4], s[b + 5]); w.w = cvtpk(s[b + 6], s[b + 7]); return __builtin_bit_cast(bf16x8, w);
}
__device__ __forceinline__ void exp_pv_sw(f32x16 (&o)[4], float m, float& l, f32x16& s0, f32x16& s1, lcp vl, int vB0, int vB1, int q4) {
    const lcp vb0[4] = {vl + vB0 + ((0 ^ q4) << 6), vl + vB0 + ((1 ^ q4) << 6), vl + vB0 + ((2 ^ q4) << 6), vl + vB0 + ((3 ^ q4) << 6)};
    const lcp vb1[4] = {vl + vB1 + ((0 ^ q4) << 6), vl + vB1 + ((1 ^ q4) << 6), vl + vB1 + ((2 ^ q4) << 6), vl + vB1 + ((3 ^ q4) << 6)};
    s16x4 alo[2][4], ahi[2][4];
#define VLOAD(kk, b) do { _Pragma("unroll") for (int c = 0; c < 4; ++c) { alo[b][c] = vtr(vb0[c] + 4096 * (kk)); ahi[b][c] = vtr(vb1[c] + 4096 * (kk)); } } while (0)
#define PVMMA(b, P) do { _Pragma("unroll") for (int c = 0; c < 4; ++c) { const s16x4 lo = alo[b][c], hi = ahi[b][c]; const bf16x8 a = {lo[0], lo[1], lo[2], lo[3], hi[0], hi[1], hi[2], hi[3]}; \
            o[c] = __builtin_amdgcn_mfma_f32_32x32x16_bf16(a, (P), o[c], 0, 0, 0); } } while (0)
#define EXP8(S, b0) do { _Pragma("unroll") for (int i = (b0); i < (b0) + 8; ++i) { S[i] = ex2(S[i]); rs += S[i]; } } while (0)
    float rs = 0.f;
    VLOAD(0, 0);
    EXP8(s0, 0); const bf16x8 p0 = pack8(s0, 0);
    __builtin_amdgcn_sched_barrier(0);
    VLOAD(1, 1); PVMMA(0, p0);
    EXP8(s0, 8); const bf16x8 p1 = pack8(s0, 8);
    __builtin_amdgcn_sched_barrier(0);
    VLOAD(2, 0); PVMMA(1, p1);
    EXP8(s1, 0); const bf16x8 p2 = pack8(s1, 0);
    __builtin_amdgcn_sched_barrier(0);
    VLOAD(3, 1); PVMMA(0, p2);
    EXP8(s1, 8); const bf16x8 p3 = pack8(s1, 8);
    __builtin_amdgcn_sched_barrier(0);
    PVMMA(1, p3);
    l += rs;
    __builtin_amdgcn_sched_barrier(0);
#undef VLOAD
#undef PVMMA
#undef EXP8
}
__device__ __forceinline__ void tile_sw(f32x16 (&o)[4], float& m, float& l, f32x16& negm, const bf16x8 (&qf)[4], lcp kb, int kx, lcp vl, int vB0, int vB1, int q4, int r0, int h, int lim, bool masked, bool first) {
    f32x16 s0, s1;
    bf16x8 kf[4][2];
#pragma unroll
    for (int ks = 0; ks < 4; ++ks) { kf[ks][0] = *(LAS const bf16x8*)(kb + (kx ^ (ks << 5))); kf[ks][1] = *(LAS const bf16x8*)(kb + (kx ^ (ks << 5)) + 4096); }
    __builtin_amdgcn_sched_barrier(0);
#pragma unroll
    for (int ks = 0; ks < 4; ++ks) {
        if (ks == 0) { s0 = __builtin_amdgcn_mfma_f32_32x32x16_bf16(kf[0][0], qf[0], negm, 0, 0, 0); s1 = __builtin_amdgcn_mfma_f32_32x32x16_bf16(kf[0][1], qf[0], negm, 0, 0, 0); }
        else { s0 = __builtin_amdgcn_mfma_f32_32x32x16_bf16(kf[ks][0], qf[ks], s0, 0, 0, 0); s1 = __builtin_amdgcn_mfma_f32_32x32x16_bf16(kf[ks][1], qf[ks], s1, 0, 0, 0); }
    }
    if (masked) {
        int hb = 4 * h + r0; asm volatile("" : "+v"(hb));
#pragma unroll
        for (int i = 0; i < 16; ++i) {
            const int kr = hb + (i & 3) + 8 * (i >> 2);
            s0[i] = kr < lim ? s0[i] : NEG;
            s1[i] = kr + 32 < lim ? s1[i] : NEG;
        }
    }
    asm volatile("s_nop 15" : "+v"(s0), "+v"(s1));
    float mxa = max3f(s0[0], s0[1], s1[0]), mxb = max3f(s0[2], s0[3], s1[1]);
    mxa = max3f(mxa, s1[2], s1[3]);
#pragma unroll
    for (int i = 4; i < 16; i += 4) { mxa = max3f(mxa, s0[i], s0[i + 1]); mxb = max3f(mxb, s0[i + 2], s0[i + 3]); mxa = max3f(mxa, s1[i], s1[i + 1]); mxb = max3f(mxb, s1[i + 2], s1[i + 3]); }
    float mx = max3f(mxa, mxb, mxb);
    mx = swapmax(mx);
    if (first || __builtin_amdgcn_ballot_w64(mx > 8.0f) != 0ull) {
        const float delta = first ? mx : fmaxf(mx, 0.f);
        const float alpha = first ? 1.0f : ex2(-delta);
        m += delta; l *= alpha;
#pragma unroll
        for (int c = 0; c < 4; ++c)
#pragma unroll
            for (int i = 0; i < 16; ++i) asm volatile("v_mul_f32 %0, %1, %0" : "+v"(o[c][i]) : "v"(alpha));
#pragma unroll
        for (int i = 0; i < 16; ++i) { s0[i] -= delta; s1[i] -= delta; negm[i] = -m; }
    }
    exp_pv_sw(o, m, l, s0, s1, vl, vB0, vB1, q4);
}

__device__ __forceinline__ void glds16(const void* gsrc, unsigned lds_dst) {
    unsigned keep;
    asm volatile("s_mov_b32 %0, m0\n\ts_mov_b32 m0, %2\n\ts_nop 0\n\tglobal_load_lds_dwordx4 %1, off\n\ts_mov_b32 m0, %0" : "=&s"(keep) : "v"(gsrc), "s"(lds_dst) : "memory");
}
__device__ __forceinline__ int clampi(int v, int lo, int hi) { return v < lo ? lo : (v > hi ? hi : v); }

__device__ __forceinline__ void diff_unit(LAS unsigned char* lds, const bf16_t* __restrict__ proj, bf16_t* __restrict__ aout, float* __restrict__ stash,
                                          int g, int b, int hh, int qb, const float* __restrict__ lamp, const float* __restrict__ subg) {
    int tid_ = threadIdx.x; asm volatile("" : "+v"(tid_));
    const int tid = tid_, lane = tid & 63, r32 = lane & 31, h = lane >> 5;
    const int w = __builtin_amdgcn_readfirstlane(tid >> 6);
    const int L = g ? LS : LP, brow0 = g ? ROWS_P + b * LS : b * LP, NT = (L + 63) >> 6;
    const bool active = (qb >= 0) || (w == 0);
    const int qrow = (qb >= 0) ? 16 + 256 * qb + 32 * w + r32 : r32;
    const bool rowvalid = (qb >= 0) || (r32 < 16);
    const int kkey = 8 * w + (lane >> 3), kchunk = (lane & 7) ^ ((kkey >> 1) & 7);
    const int vkey0 = 8 * w + (lane >> 4), vkey1 = vkey0 + 4;
    const int vchunk0 = (lane & 15) ^ (((vkey0 & 3) << 2) | ((vkey0 >> 2) & 3)), vchunk1 = (lane & 15) ^ (((vkey1 & 3) << 2) | ((vkey1 >> 2) & 3));
    const bf16_t* kbase = proj + (size_t)brow0 * NIN + C_BK + hh * 128 + kchunk * 8;
    const bf16_t* vbase0 = proj + (size_t)brow0 * NIN + C_BV + hh * 128 + vchunk0 * 8;
    const bf16_t* vbase1 = proj + (size_t)brow0 * NIN + C_BV + hh * 128 + vchunk1 * 8;
    const int fsw = (r32 >> 1) & 7;
    const lcp kb = (lcp)lds + r32 * 128 + ((h ^ (fsw & 1)) * 16);
    const int kx = (fsw >> 1) << 5;
    const int q4 = (lane & 15) >> 2, blk = (lane >> 4) & 1, p4 = lane & 3;
    const int vB0 = (4 * h + q4) * 256 + (((2 * blk + (p4 >> 1)) ^ h) * 16) + 8 * (p4 & 1);
    const int vB1 = (vB0 ^ 32) + 2048;

    f32x16 o[4]; float m = 0.f, l = 0.f; bf16x8 qf[4]; f32x16 negm;
#pragma unroll
    for (int i = 0; i < 16; ++i) negm[i] = 0.f;
#pragma unroll
    for (int c = 0; c < 4; ++c)
#pragma unroll
        for (int i = 0; i < 16; ++i) o[c][i] = 0.f;
    const int total = 2 * NT;
    const unsigned ldsw_k = (unsigned)w * 1024u, ldsw_v = (unsigned)w * 2048u;
    const unsigned lds0 = (unsigned)(size_t)lds;
    const bf16_t* kp = kbase + (size_t)kkey * NIN; const bf16_t* vp0 = vbase0 + (size_t)vkey0 * NIN; const bf16_t* vp1 = vbase1 + (size_t)vkey1 * NIN;
#define DIFF_DMA(tn, kslot, vslot) do { \
        glds16(kp, (unsigned)__builtin_amdgcn_readfirstlane(lds0 + SW_K + (kslot) * 8192 + ldsw_k)); \
        glds16(vp0, (unsigned)__builtin_amdgcn_readfirstlane(lds0 + SW_V + (vslot) * 16384 + ldsw_v)); \
        glds16(vp1, (unsigned)__builtin_amdgcn_readfirstlane(lds0 + SW_V + (vslot) * 16384 + ldsw_v + 1024u)); \
        { const bool wrap_ = ((tn) + 1 == NT);                   \
          const long dk_ = wrap_ ? (long)64 - (long)(NT - 1) * 64 * NIN : (long)64 * NIN, dv_ = wrap_ ? -(long)(NT - 1) * 64 * NIN : (long)64 * NIN; \
          kp += dk_; vp0 += dv_; vp1 += dv_; } } while (0)
    DIFF_DMA(0, 0, 0); DIFF_DMA(1, 1, 1);
    asm volatile("s_waitcnt vmcnt(3)" ::: "memory");
    __builtin_amdgcn_s_barrier(); asm volatile("" ::: "memory");
    int k_cur = 0, k_nn = 2, v_cur = 0, v_nn = 2;
    for (int t = 0; t < total; ++t) {
        const int c = t >= NT ? 1 : 0, tt = t - c * NT;
        if (tt == 0) {
            if (c == 1 && active) {
                const float inv = __builtin_amdgcn_rcpf(swapsum(l));
                int td = tid; asm volatile("" : "+v"(td));
                float* sp = stash + ((size_t)blockIdx.x * 512 + (td & ~63)) * 64 + (td & 63) * 4;
#pragma unroll
                for (int cc = 0; cc < 4; ++cc)
#pragma unroll
                    for (int g4 = 0; g4 < 4; ++g4) {
                        f32x4 v = {o[cc][4 * g4] * inv, o[cc][4 * g4 + 1] * inv, o[cc][4 * g4 + 2] * inv, o[cc][4 * g4 + 3] * inv};
                        *(f32x4*)(sp + (cc * 4 + g4) * 256) = v;
                        o[cc][4 * g4] = 0.f; o[cc][4 * g4 + 1] = 0.f; o[cc][4 * g4 + 2] = 0.f; o[cc][4 * g4 + 3] = 0.f;
                    }
                m = 0.f; l = 0.f;
#pragma unroll
                for (int i = 0; i < 16; ++i) negm[i] = 0.f;
            }
            int qr = qrow; asm volatile("" : "+v"(qr));
            const bf16_t* qp = proj + (size_t)(brow0 + qr) * NIN + C_BQ + hh * 128 + h * 8 + c * 64;
#pragma unroll
            for (int ks = 0; ks < 4; ++ks) qf[ks] = *(const bf16x8*)(qp + ks * 16);
            asm volatile("" : "+v"(qf[0]), "+v"(qf[1]), "+v"(qf[2]), "+v"(qf[3]) :: "memory");
        }
        if (t + 2 < total) DIFF_DMA(t + 2, k_nn, v_nn);
        if (active) {
            const int bo_k = SW_K + k_cur * 8192;
            const lcp vl = (lcp)lds + SW_V + v_cur * 16384;
            tile_sw(o, m, l, negm, qf, kb + bo_k, kx, vl, vB0, vB1, q4, 64 * tt, h, L, tt == NT - 1, tt == 0);
        }
        if (t + 2 < total) asm volatile("s_waitcnt vmcnt(3)" ::: "memory"); else asm volatile("s_waitcnt vmcnt(0)" ::: "memory");
        __builtin_amdgcn_s_barrier(); asm volatile("" ::: "memory");
        k_cur = (k_cur == 2) ? 0 : k_cur + 1; k_nn = (k_nn == 2) ? 0 : k_nn + 1;
        v_cur = (v_cur + 1) & 3; v_nn = (v_nn + 1) & 3;
    }
#undef DIFF_DMA
    if (active) {
        int td = tid, qr = qrow; asm volatile("" : "+v"(td), "+v"(qr));
        const float lam = lamp[0], oml = lamp[1];
        const float inv = __builtin_amdgcn_rcpf(swapsum(l)) * lam;
        const float* sp = stash + ((size_t)blockIdx.x * 512 + (td & ~63)) * 64 + (td & 63) * 4;
        float ss = 0.f;
#pragma unroll
        for (int cc = 0; cc < 4; ++cc)
#pragma unroll
            for (int g4 = 0; g4 < 4; ++g4) {
                const f32x4 sv = *(const f32x4*)(sp + (cc * 4 + g4) * 256);
#pragma unroll
                for (int e = 0; e < 4; ++e) { const float v = sv[e] - o[cc][4 * g4 + e] * inv; o[cc][4 * g4 + e] = v; ss += v * v; }
                if (g4 == 3) __builtin_amdgcn_sched_barrier(0);
            }
        ss = swapsum(ss);
        const float rstd = __builtin_amdgcn_rsqf(ss * (1.0f / 128.0f) + EPS) * oml;
        if (rowvalid) {
            const bf16_t* gp = proj + (size_t)(brow0 + qr) * NIN + C_BG + hh * 128;
            bf16_t* op = aout + (size_t)(brow0 + qr) * DM + 512 + hh * 128;
#pragma unroll
            for (int cc = 0; cc < 4; ++cc)
#pragma unroll
                for (int k2 = 0; k2 < 2; ++k2) {
                    float x[4], y[4];
#pragma unroll
                    for (int e = 0; e < 4; ++e) {
                        auto rr = __builtin_amdgcn_permlane32_swap(__float_as_uint(o[cc][8 * k2 + e]), __float_as_uint(o[cc][8 * k2 + 4 + e]), false, false);
                        x[e] = __uint_as_float(rr[0]); y[e] = __uint_as_float(rr[1]);
                    }
                    const int d = 32 * cc + 16 * k2 + 8 * h;
                    const u32x4 gt = *(const u32x4*)(gp + d);
                    const f32x4 sg0 = *(const f32x4*)(subg + d), sg1 = *(const f32x4*)(subg + d + 4);
                    const float v0 = x[0] * rstd * sg0[0] * silu(bf_lo(gt.x));
                    const float v1 = x[1] * rstd * sg0[1] * silu(bf_hi(gt.x));
                    const float v2 = x[2] * rstd * sg0[2] * silu(bf_lo(gt.y));
                    const float v3 = x[3] * rstd * sg0[3] * silu(bf_hi(gt.y));
                    const float v4 = y[0] * rstd * sg1[0] * silu(bf_lo(gt.z));
                    const float v5 = y[1] * rstd * sg1[1] * silu(bf_hi(gt.z));
                    const float v6 = y[2] * rstd * sg1[2] * silu(bf_lo(gt.w));
                    const float v7 = y[3] * rstd * sg1[3] * silu(bf_hi(gt.w));
                    u32x4 ov; ov.x = cvtpk(v0, v1); ov.y = cvtpk(v2, v3); ov.z = cvtpk(v4, v5); ov.w = cvtpk(v6, v7);
                    *(u32x4*)(op + d) = ov;
                    __builtin_amdgcn_sched_barrier(0);
                }
        }
    }
}

constexpr int WK = 0, WV = 49152;
enum { M_NONE = 0, M_META = 1, M_BAND = 2, M_METAQ = 3 };
__device__ __forceinline__ void wait_vm(int n) {
    switch (n) {
        case 0: asm volatile("s_waitcnt vmcnt(0)" ::: "memory"); break;
        case 2: asm volatile("s_waitcnt vmcnt(2)" ::: "memory"); break;
        case 4: asm volatile("s_waitcnt vmcnt(4)" ::: "memory"); break;
        case 6: asm volatile("s_waitcnt vmcnt(6)" ::: "memory"); break;
        case 8: asm volatile("s_waitcnt vmcnt(8)" ::: "memory"); break;
        default: asm volatile("s_waitcnt vmcnt(10)" ::: "memory"); break;
    }
}
__device__ __forceinline__ void tile_win(f32x16 (&o)[2], float& m, float& l, f32x16& negm, const bf16x8 (&qf)[4], lcp kb, int kx, lcp vl, int vB0, int q1, int r0, int h, int S, int qi, int kind, bool first) {
    f32x16 s0, s1;
    bf16x8 kf[4][2];
#pragma unroll
    for (int ks = 0; ks < 4; ++ks) { kf[ks][0] = *(LAS const bf16x8*)(kb + (kx ^ (ks << 5))); kf[ks][1] = *(LAS const bf16x8*)(kb + (kx ^ (ks << 5)) + 4096); }
    __builtin_amdgcn_sched_barrier(0);
#pragma unroll
    for (int ks = 0; ks < 4; ++ks) {
        if (ks == 0) { s0 = __builtin_amdgcn_mfma_f32_32x32x16_bf16(kf[0][0], qf[0], negm, 0, 0, 0); s1 = __builtin_amdgcn_mfma_f32_32x32x16_bf16(kf[0][1], qf[0], negm, 0, 0, 0); }
        else { s0 = __builtin_amdgcn_mfma_f32_32x32x16_bf16(kf[ks][0], qf[ks], s0, 0, 0, 0); s1 = __builtin_amdgcn_mfma_f32_32x32x16_bf16(kf[ks][1], qf[ks], s1, 0, 0, 0); }
    }
    if (kind != M_NONE) {
        int hb = 4 * h + r0; asm volatile("" : "+v"(hb));
        if (kind == M_META) {
#pragma unroll
            for (int i = 0; i < 16; ++i) { const int kr = hb + (i & 3) + 8 * (i >> 2); s0[i] = kvalid<K_META>(kr, S, qi) ? s0[i] : NEG; s1[i] = kvalid<K_META>(kr + 32, S, qi) ? s1[i] : NEG; }
        } else if (kind == M_BAND) {
#pragma unroll
            for (int i = 0; i < 16; ++i) { const int kr = hb + (i & 3) + 8 * (i >> 2); s0[i] = kvalid<K_BAND>(kr, S, qi) ? s0[i] : NEG; s1[i] = kvalid<K_BAND>(kr + 32, S, qi) ? s1[i] : NEG; }
        } else {
#pragma unroll
            for (int i = 0; i < 16; ++i) { const int kr = hb + (i & 3) + 8 * (i >> 2); s0[i] = kvalid<K_METAQ>(kr, S, qi) ? s0[i] : NEG; s1[i] = kvalid<K_METAQ>(kr + 32, S, qi) ? s1[i] : NEG; }
        }
    }
    asm volatile("s_nop 15" : "+v"(s0), "+v"(s1));
    float mxa = max3f(s0[0], s0[1], s1[0]), mxb = max3f(s0[2], s0[3], s1[1]);
    mxa = max3f(mxa, s1[2], s1[3]);
#pragma unroll
    for (int i = 4; i < 16; i += 4) { mxa = max3f(mxa, s0[i], s0[i + 1]); mxb = max3f(mxb, s0[i + 2], s0[i + 3]); mxa = max3f(mxa, s1[i], s1[i + 1]); mxb = max3f(mxb, s1[i + 2], s1[i + 3]); }
    float mx = max3f(mxa, mxb, mxb);
    mx = swapmax(mx);
    if (first || __builtin_amdgcn_ballot_w64(mx > 8.0f) != 0ull) {
        const float delta = first ? mx : fmaxf(mx, 0.f);
        const float alpha = first ? 1.0f : ex2(-delta);
        m += delta; l *= alpha;
#pragma unroll
        for (int c = 0; c < 2; ++c)
#pragma unroll
            for (int i = 0; i < 16; ++i) asm volatile("v_mul_f32 %0, %1, %0" : "+v"(o[c][i]) : "v"(alpha));
#pragma unroll
        for (int i = 0; i < 16; ++i) { s0[i] -= delta; s1[i] -= delta; negm[i] = -m; }
    }
    const lcp vb0[2] = {vl + vB0 + ((0 ^ q1) << 6), vl + vB0 + ((1 ^ q1) << 6)};
    s16x4 alo[2][2], ahi[2][2];
#define VLOAD(kk, b) do { _Pragma("unroll") for (int c = 0; c < 2; ++c) { alo[b][c] = vtr(vb0[c] + 2048 * (kk)); ahi[b][c] = vtr(vb0[c] + 2048 * (kk) + 1024); } } while (0)
#define PVMMA(b, P) do { _Pragma("unroll") for (int c = 0; c < 2; ++c) { const s16x4 lo = alo[b][c], hi = ahi[b][c]; const bf16x8 a = {lo[0], lo[1], lo[2], lo[3], hi[0], hi[1], hi[2], hi[3]}; \
            o[c] = __builtin_amdgcn_mfma_f32_32x32x16_bf16(a, (P), o[c], 0, 0, 0); } } while (0)
#define EXP8(S_, b0) do { _Pragma("unroll") for (int i = (b0); i < (b0) + 8; ++i) { S_[i] = ex2(S_[i]); rs += S_[i]; } } while (0)
    float rs = 0.f;
    VLOAD(0, 0);
    EXP8(s0, 0); const bf16x8 p0 = pack8(s0, 0);
    __builtin_amdgcn_sched_barrier(0);
    VLOAD(1, 1); PVMMA(0, p0);
    EXP8(s0, 8); const bf16x8 p1 = pack8(s0, 8);
    __builtin_amdgcn_sched_barrier(0);
    VLOAD(2, 0); PVMMA(1, p1);
    EXP8(s1, 0); const bf16x8 p2 = pack8(s1, 0);
    __builtin_amdgcn_sched_barrier(0);
    VLOAD(3, 1); PVMMA(0, p2);
    EXP8(s1, 8); const bf16x8 p3 = pack8(s1, 8);
    __builtin_amdgcn_sched_barrier(0);
    PVMMA(1, p3);
    l += rs;
    __builtin_amdgcn_sched_barrier(0);
#undef VLOAD
#undef PVMMA
#undef EXP8
}
__device__ __forceinline__ void win_unit(LAS unsigned char* lds, const bf16_t* __restrict__ proj, bf16_t* __restrict__ aout,
                                         int g, int b, int kh, int qb, const float* __restrict__ sink) {
    int tid_ = threadIdx.x; asm volatile("" : "+v"(tid_));
    const int tid = tid_, lane = tid & 63, r32 = lane & 31, h = lane >> 5;
    const int w = __builtin_amdgcn_readfirstlane(tid >> 6);
    const int L = g ? LS : LP, S = g ? SS : SP, brow0 = g ? ROWS_P + b * LS : b * LP;
    const bool real = qb >= 0;
    const bool active = real || (w < 2);
    const int ntile = real ? 6 : 3;
    const int hq = real ? 4 * kh + (w & 3) : 4 * kh + 2 * (w & 1) + (r32 >> 4);
    const int qi = real ? 64 * qb + 32 * (w >> 2) + r32 : (r32 & 15);
    const int qrow = real ? 16 + qi : qi;
    const int band0 = 16 + 64 * qb - 128;
    const int kkey = 8 * w + (lane >> 3), kchunk = (lane & 7) ^ ((kkey >> 1) & 7), vchunk = (lane & 7) ^ (((kkey >> 1) & 1) << 2);
    const bf16_t* kbase = proj + (size_t)brow0 * NIN + C_AK + kh * 64 + kchunk * 8;
    const bf16_t* vbase = proj + (size_t)brow0 * NIN + C_AV + kh * 64 + vchunk * 8;
    const int fsw = (r32 >> 1) & 7;
    const lcp kb = (lcp)lds + WK + r32 * 128 + ((h ^ (fsw & 1)) * 16);
    const int kx = (fsw >> 1) << 5;
    const int q4 = (lane & 15) >> 2, blk = (lane >> 4) & 1, p4 = lane & 3;
    const int vB0 = (4 * h + q4) * 128 + (2 * blk + (p4 >> 1)) * 16 + 8 * (p4 & 1);
    const unsigned lds0 = (unsigned)(size_t)lds;

    f32x16 o[2]; float m = 0.f, l = 0.f; bf16x8 qf[4]; f32x16 negm;
#pragma unroll
    for (int i = 0; i < 16; ++i) { o[0][i] = 0.f; o[1][i] = 0.f; negm[i] = 0.f; }
    {
        const bf16_t* qptr = proj + (size_t)(brow0 + qrow) * NIN + C_AQ + hq * 64 + h * 8;
#pragma unroll
        for (int ks = 0; ks < 4; ++ks) qf[ks] = *(const bf16x8*)(qptr + ks * 16);
        asm volatile("" : "+v"(qf[0]), "+v"(qf[1]), "+v"(qf[2]), "+v"(qf[3]) :: "memory");
    }
#define WIN_R0(t) (real ? ((t) == 0 ? 0 : band0 + 64 * ((t) - 1)) : 64 * (t))
    for (int t = 0; t < ntile; ++t) {
        const size_t ro = (size_t)clampi(WIN_R0(t) + kkey, 0, L - 1) * NIN;
        glds16(kbase + ro, (unsigned)__builtin_amdgcn_readfirstlane(lds0 + WK + t * 8192 + w * 1024));
        glds16(vbase + ro, (unsigned)__builtin_amdgcn_readfirstlane(lds0 + WV + t * 8192 + w * 1024));
    }
    for (int t = 0; t < ntile; ++t) {
        wait_vm(2 * (ntile - 1 - t));
        __builtin_amdgcn_s_barrier(); asm volatile("" ::: "memory");
        if (active) {
            const int r0 = WIN_R0(t);
            int kind;
            if (!real) kind = M_METAQ;
            else if (t == 0) kind = M_META;
            else {
                const int u0 = r0 - 16, q0 = 64 * qb;
                kind = (u0 >= 0 && u0 + 63 < S && u0 + 63 - q0 <= 128 && q0 + 63 - u0 <= 128) ? M_NONE : M_BAND;
            }
            tile_win(o, m, l, negm, qf, kb + t * 8192, kx, (lcp)lds + WV + t * 8192, vB0, q4 >> 1, r0, h, S, qi, kind, t == 0);
        }
    }
#undef WIN_R0
    __builtin_amdgcn_s_barrier(); asm volatile("" ::: "memory");
    if (active) {
        int qr = qrow; asm volatile("" : "+v"(qr));
        const float lt = swapsum(l) + ex2(sink[hq] * LOG2E - m);
        const float inv = __builtin_amdgcn_rcpf(lt);
        const bf16_t* gp = proj + (size_t)(brow0 + qr) * NIN + C_AG + hq * 64;
        bf16_t* op = aout + (size_t)(brow0 + qr) * DM + hq * 64;
#pragma unroll
        for (int cc = 0; cc < 2; ++cc)
#pragma unroll
            for (int g4 = 0; g4 < 4; ++g4) {
                const int d = 32 * cc + 8 * g4 + 4 * h;
                const u32x2 gt = *(const u32x2*)(gp + d);
                const float v0 = o[cc][4 * g4 + 0] * inv * silu(bf_lo(gt.x));
                const float v1 = o[cc][4 * g4 + 1] * inv * silu(bf_hi(gt.x));
                const float v2 = o[cc][4 * g4 + 2] * inv * silu(bf_lo(gt.y));
                const float v3 = o[cc][4 * g4 + 3] * inv * silu(bf_hi(gt.y));
                u32x2 ov; ov.x = cvtpk(v0, v1); ov.y = cvtpk(v2, v3);
                *(u32x2*)(op + d) = ov;
            }
    }
}

__device__ __forceinline__ void attn_phase(LAS unsigned char* lds, const bf16_t* proj, bf16_t* aout, float* stash, unsigned* ctr, bool last,
                                           const float* lamp, const float* subg, const float* sink) {
    const int nP = last ? 16 : 17, nS = last ? 8 : 9;
    const int e1 = 8 * nP, e2 = e1 + 8 * nS, e3 = e2 + 256, e4 = e3 + 128, e5 = e4 + (last ? 0 : 8);
    LAS volatile int* su = (LAS volatile int*)(lds + OFF_UNIT);
    const int xcd = (int)(__builtin_amdgcn_s_getreg((3 << 11) | 20) & 7u);
    int kq = 0;
    for (;;) {
        if (threadIdx.x == 0) {
            int u = -1, x = 0;
            while (kq < 8) {
                x = (xcd + kq) & 7;
                int z; asm volatile("v_mov_b32 %0, 0" : "=v"(z));
                const int v = (int)__hip_atomic_fetch_add(ctr + 16 * x + z, 1u, __ATOMIC_RELAXED, __HIP_MEMORY_SCOPE_AGENT);
                if (v < e5) { u = v; break; }
                ++kq;
            }
            su[0] = u; su[1] = x;
        }
        __syncthreads();
        const int u = su[0], x = su[1];
        __syncthreads();
        if (u < 0) break;
        if (u < e2) {
            int g, bh, qb;
            if (u < e1) { const int j = u / nP, r = u - j * nP; g = 0; bh = x + 8 * j; qb = r < 16 ? r : -1; }
            else { const int v = u - e1, j = v / nS, r = v - j * nS; g = 1; bh = x + 8 * j; qb = r < 8 ? r : -1; }
            diff_unit(lds, proj, aout, stash, g, bh >> 2, bh & 3, qb, lamp, subg);
        } else {
            int g, bk, qb;
            if (u < e3) { const int v = u - e2; g = 0; bk = x + 8 * (v >> 6); qb = v & 63; }
            else if (u < e4) { const int v = u - e3; g = 1; bk = x + 8 * (v >> 5); qb = v & 31; }
            else { const int v = u - e4; g = v >> 2; bk = x + 8 * (v & 3); qb = -1; }
            win_unit(lds, proj, aout, g, bk >> 1, bk & 1, qb, sink);
        }
    }
}
}

constexpr int NWAVES = 8;
constexpr int LDS_BYTES = 147456;
constexpr int N_PHASES = 1 + 4 * DEPTH;

__device__ __forceinline__ void grid_bar(unsigned* cnt, unsigned target) {
    asm volatile("s_waitcnt vmcnt(0)" ::: "memory");
    __syncthreads();
    if (threadIdx.x == 0) {
        __builtin_amdgcn_fence(__ATOMIC_RELEASE, "agent");
        asm volatile("s_waitcnt vmcnt(0)" ::: "memory");
        int z; asm volatile("v_mov_b32 %0, 0" : "=v"(z));
        __hip_atomic_fetch_add(cnt + z, 1u, __ATOMIC_RELAXED, __HIP_MEMORY_SCOPE_AGENT);
        while (__hip_atomic_load(cnt, __ATOMIC_RELAXED, __HIP_MEMORY_SCOPE_AGENT) < target) __builtin_amdgcn_s_sleep(2);
        __builtin_amdgcn_fence(__ATOMIC_ACQUIRE, "agent");
        asm volatile("s_waitcnt vmcnt(0)" ::: "memory");
    }
    __syncthreads();
}

struct Args { const float* in[13]; float* out; unsigned char* ws; int ph_lo, ph_hi; };

__device__ __forceinline__ int src_col(int n) {
    const bool r = (n < C_AV) || (n >= C_BQ && n < C_BV);
    if (!r) return n;
    const int w = n & 63;
    return (n & ~63) + (w >> 1) + 32 * (w & 1);
}
__device__ __forceinline__ void transpose_item(const float* __restrict__ W, int N, bf16_t* __restrict__ WT, LAS float* scr, int item, int lane, bool permute) {
    const int nblk = N / 32, kb = item / nblk, nb = item % nblk, k0 = 64 * kb, n0 = 32 * nb;
    const int sc = permute ? src_col(n0 + (lane & 31)) : n0 + (lane & 31);
#pragma unroll 8
    for (int i = 0; i < 32; ++i) { const int kk = 2 * i + (lane >> 5); scr[kk * 33 + (lane & 31)] = W[(size_t)(k0 + kk) * N + sc]; }
    asm volatile("s_waitcnt lgkmcnt(0)" ::: "memory");
    const int c = lane & 7;
#pragma unroll
    for (int j = 0; j < 4; ++j) {
        const int n = (lane >> 3) + 8 * j; const LAS float* s = scr + (8 * c) * 33 + n;
        const int nn = n0 + n; const float sc = (permute && (nn < C_AK || (nn >= C_BQ && nn < C_BK))) ? 0.125f * 1.4426950408889634f : 1.0f;
        u32x4 o; o.x = cvtpk(s[0 * 33] * sc, s[1 * 33] * sc); o.y = cvtpk(s[2 * 33] * sc, s[3 * 33] * sc); o.z = cvtpk(s[4 * 33] * sc, s[5 * 33] * sc); o.w = cvtpk(s[6 * 33] * sc, s[7 * 33] * sc);
        *(u32x4*)(WT + (size_t)nn * 1024 + k0 + 8 * c) = o;
    }
    asm volatile("s_waitcnt lgkmcnt(0)" ::: "memory");
}

__device__ __forceinline__ const float* h0_row(const Args& a, int g, int b, int pos) {
    if (pos < 16) return a.in[2] + (size_t)pos * DM;
    return (g ? a.in[1] : a.in[0]) + ((size_t)b * (g ? SS : SP) + (pos - 16)) * DM;
}

__device__ __forceinline__ void prologue(const Args& a, LAS unsigned char* lds) {
    int tid_ = threadIdx.x; asm volatile("" : "+v"(tid_));
    const int tid = tid_, lane = tid & 63, wave = tid >> 6;
    const int gw = blockIdx.x * NWAVES + wave, NGW = gridDim.x * NWAVES;
    unsigned char* ws = a.ws;
    LAS float* scr = (LAS float*)(lds + wave * 16384);
    constexpr int I_IN = 16 * (NIN / 32), I_OUT = 16 * (DM / 32);
    constexpr int NITEMS = DEPTH * (I_IN + I_OUT);
    for (int it = gw; it < NITEMS; it += NGW) {
        if (it < DEPTH * I_IN) { const int l = it / I_IN, r = it - l * I_IN;
            transpose_item(a.in[3] + (size_t)l * DM * NIN, NIN, (bf16_t*)(ws + WS_WIN) + (size_t)l * NIN * DM, scr, r, lane, true); }
        else { const int q = it - DEPTH * I_IN, l = q / I_OUT, r = q - l * I_OUT;
            transpose_item(a.in[4] + (size_t)l * DM * DM, DM, (bf16_t*)(ws + WS_WOUT) + (size_t)l * DM * DM, scr, r, lane, false); }
    }
    {
        f32x2* rope = (f32x2*)(ws + WS_ROPE);
        for (int e = blockIdx.x * 512 + tid; e < LP * 32; e += gridDim.x * 512) {
            const int pos = e >> 5, i = e & 31;
            const float inv_freq = __builtin_amdgcn_exp2f(-(float)i * (13.287712379549449f / 32.0f));
            const float ang = (float)pos * inv_freq;
            const float rev = ang * 0.15915494309189535f;
            const float fr = rev - floorf(rev);
            f32x2 cs; cs.x = __builtin_amdgcn_cosf(fr); cs.y = __builtin_amdgcn_sinf(fr);
            rope[e] = cs;
        }
    }
    {
        const float* pg = a.in[5];
        bf16_t* hn = (bf16_t*)(ws + WS_HN);
        for (int row0 = gw; row0 < MROWS; row0 += 2 * NGW) {
            f32x4 v[2][4]; bool live[2]; int rows[2];
#pragma unroll
            for (int u = 0; u < 2; ++u) {
                const int row = row0 + u * NGW; live[u] = row < MROWS; rows[u] = live[u] ? row : MROWS - 1;
                int g, b, pos; row_decode(rows[u], g, b, pos);
                const float* x = h0_row(a, g, b, pos);
#pragma unroll
                for (int j = 0; j < 2; ++j) { v[u][2 * j] = *(const f32x4*)(x + 512 * j + lane * 8); v[u][2 * j + 1] = *(const f32x4*)(x + 512 * j + lane * 8 + 4); }
            }
#pragma unroll
            for (int u = 0; u < 2; ++u) {
                if (!live[u]) continue;
                float ss = 0.f;
#pragma unroll
                for (int j = 0; j < 4; ++j) ss += (v[u][j][0] * v[u][j][0] + v[u][j][1] * v[u][j][1]) + (v[u][j][2] * v[u][j][2] + v[u][j][3] * v[u][j][3]);
                const float rstd = __builtin_amdgcn_rsqf(wave_sum(ss, lane) * (1.0f / DM) + EPS);
#pragma unroll
                for (int j = 0; j < 2; ++j) {
                    const f32x4 g0 = *(const f32x4*)(pg + 512 * j + lane * 8), g1 = *(const f32x4*)(pg + 512 * j + lane * 8 + 4);
                    const f32x4 a0 = v[u][2 * j] * rstd * g0, a1 = v[u][2 * j + 1] * rstd * g1;
                    u32x4 o; o.x = cvtpk(a0[0], a0[1]); o.y = cvtpk(a0[2], a0[3]); o.z = cvtpk(a1[0], a1[1]); o.w = cvtpk(a1[2], a1[3]);
                    *(u32x4*)(hn + (size_t)rows[u] * DM + 512 * j + lane * 8) = o;
                }
            }
        }
    }
    {
        u32x4* pad = (u32x4*)(ws + WS_PROJ + (size_t)MROWS * NIN * 2);
        const u32x4 z = {0u, 0u, 0u, 0u};
        for (int e = blockIdx.x * 512 + tid; e < (64 * NIN * 2) / 16; e += gridDim.x * 512) pad[e] = z;
    }
    if (blockIdx.x == 0 && wave == 0) {
        float* lamv = (float*)(ws + WS_LAM);
        for (int l = 0; l < DEPTH; ++l) {
            const float s1 = wave_sum(a.in[8][l * 64 + lane] * a.in[9][l * 64 + lane], lane);
            const float s2 = wave_sum(a.in[10][l * 64 + lane] * a.in[11][l * 64 + lane], lane);
            const float li = 0.8f - 0.6f * expf(-0.3f * (float)l);
            if (lane == 0) { lamv[2 * l] = expf(s1) - expf(s2) + li; lamv[2 * l + 1] = 1.0f - li; }
        }
    }
}

struct NormRow { const float* hold; float* hnew; u32x4 r[2]; f32x4 ho[4]; bool live; bool meta; };
__device__ __forceinline__ void norm_load(const Args& a, int l, bool last, int row, int lane, const bf16_t* ob, float* metah, NormRow& R) {
    R.live = row < MROWS;
    const int rr = R.live ? row : MROWS - 1;
    int g, b, pos; row_decode(rr, g, b, pos);
    if (last && pos < 16) R.live = false;
    R.meta = pos < 16;
    if (pos < 16) { R.hnew = metah + ((size_t)(g * NB + b) * 16 + pos) * DM; R.hold = (l == 0) ? a.in[2] + (size_t)pos * DM : R.hnew; }
    else { const size_t off = (g ? (size_t)NB * SP * DM : 0) + ((size_t)b * (g ? SS : SP) + (pos - 16)) * DM; R.hnew = a.out + off;
           R.hold = (l == 0) ? (g ? a.in[1] : a.in[0]) + ((size_t)b * (g ? SS : SP) + (pos - 16)) * DM : R.hnew; }
#pragma unroll
    for (int j = 0; j < 2; ++j) R.r[j] = *(const u32x4*)(ob + (size_t)rr * DM + 512 * j + lane * 8);
    if (l == 0 || R.meta) {
#pragma unroll
        for (int j = 0; j < 4; ++j) R.ho[j] = *(const f32x4*)(R.hold + 512 * (j >> 1) + lane * 8 + 4 * (j & 1));
    } else {
        const bf16_t* hb = (const bf16_t*)R.hold;
#pragma unroll
        for (int j = 0; j < 2; ++j) {
            const u32x4 q = *(const u32x4*)(hb + 512 * j + lane * 8);
            R.ho[2 * j] = (f32x4){bf_lo(q.x), bf_hi(q.x), bf_lo(q.y), bf_hi(q.y)};
            R.ho[2 * j + 1] = (f32x4){bf_lo(q.z), bf_hi(q.z), bf_lo(q.w), bf_hi(q.w)};
        }
    }
}
__device__ __forceinline__ void norm_compute(const NormRow& R, int row, int lane, bool last, const f32x4 (&pgv)[4], const f32x4 (&prv)[4], bf16_t* hn) {
    if (!R.live) return;
    f32x4 ov[4]; float ss = 0.f;
#pragma unroll
    for (int j = 0; j < 2; ++j) {
        const u32x4 r = R.r[j];
        ov[2 * j] = (f32x4){bf_lo(r.x), bf_hi(r.x), bf_lo(r.y), bf_hi(r.y)};
        ov[2 * j + 1] = (f32x4){bf_lo(r.z), bf_hi(r.z), bf_lo(r.w), bf_hi(r.w)};
    }
#pragma unroll
    for (int j = 0; j < 4; ++j) ss += (ov[j][0] * ov[j][0] + ov[j][1] * ov[j][1]) + (ov[j][2] * ov[j][2] + ov[j][3] * ov[j][3]);
    const float rstd = __builtin_amdgcn_rsqf(wave_sum(ss, lane) * (1.0f / DM) + EPS);
    f32x4 hv[4]; float s2 = 0.f;
#pragma unroll
    for (int j = 0; j < 4; ++j) {
        const int c0 = 512 * (j >> 1) + lane * 8 + 4 * (j & 1);
        hv[j] = R.ho[j] + ov[j] * rstd * pgv[j];
        s2 += (hv[j][0] * hv[j][0] + hv[j][1] * hv[j][1]) + (hv[j][2] * hv[j][2] + hv[j][3] * hv[j][3]);
    }
    if (last || R.meta) {
#pragma unroll
        for (int j = 0; j < 4; ++j) { if (last) __builtin_nontemporal_store(hv[j], (f32x4*)(R.hnew + 512 * (j >> 1) + lane * 8 + 4 * (j & 1))); else *(f32x4*)(R.hnew + 512 * (j >> 1) + lane * 8 + 4 * (j & 1)) = hv[j]; }
    } else {
        bf16_t* hb = (bf16_t*)R.hnew;
#pragma unroll
        for (int j = 0; j < 2; ++j) {
            u32x4 o; o.x = cvtpk(hv[2 * j][0], hv[2 * j][1]); o.y = cvtpk(hv[2 * j][2], hv[2 * j][3]); o.z = cvtpk(hv[2 * j + 1][0], hv[2 * j + 1][1]); o.w = cvtpk(hv[2 * j + 1][2], hv[2 * j + 1][3]);
            __builtin_nontemporal_store(o, (u32x4*)(hb + 512 * j + lane * 8));
        }
    }
    if (!last) {
        const float rstd2 = __builtin_amdgcn_rsqf(wave_sum(s2, lane) * (1.0f / DM) + EPS);
#pragma unroll
        for (int j = 0; j < 2; ++j) {
            const int c0 = 512 * j + lane * 8;
            const f32x4 a0 = hv[2 * j] * rstd2 * prv[2 * j], a1 = hv[2 * j + 1] * rstd2 * prv[2 * j + 1];
            u32x4 o; o.x = cvtpk(a0[0], a0[1]); o.y = cvtpk(a0[2], a0[3]); o.z = cvtpk(a1[0], a1[1]); o.w = cvtpk(a1[2], a1[3]);
            *(u32x4*)(hn + (size_t)row * DM + c0) = o;
        }
    }
}
__device__ __forceinline__ void norm_phase(const Args& a, int l) {
    int tid_ = threadIdx.x; asm volatile("" : "+v"(tid_));
    const int tid = tid_, lane = tid & 63, wave = tid >> 6;
    const int gw = blockIdx.x * NWAVES + wave, NGW = gridDim.x * NWAVES;
    unsigned char* ws = a.ws;
    const bf16_t* ob = (const bf16_t*)(ws + WS_PROJ);
    bf16_t* hn = (bf16_t*)(ws + WS_HN);
    float* metah = (float*)(ws + WS_METAH);
    const float* postg = a.in[6] + (size_t)l * DM;
    const bool last = (l == DEPTH - 1);
    const float* preg = a.in[5] + (size_t)(last ? l : l + 1) * DM;
    f32x4 pgv[4], prv[4];
#pragma unroll
    for (int j = 0; j < 4; ++j) { const int c0 = 512 * (j >> 1) + lane * 8 + 4 * (j & 1); pgv[j] = *(const f32x4*)(postg + c0); prv[j] = *(const f32x4*)(preg + c0); }
    for (int row = gw; row < MROWS; row += 2 * NGW) {
        NormRow A, B;
        norm_load(a, l, last, row, lane, ob, metah, A);
        norm_load(a, l, last, row + NGW, lane, ob, metah, B);
        norm_compute(A, row, lane, last, pgv, prv, hn);
        norm_compute(B, row + NGW, lane, last, pgv, prv, hn);
    }
}

__global__ void __launch_bounds__(NWAVES * 64, 2) fwd_kernel(Args a) {
    extern __shared__ __attribute__((aligned(16))) unsigned char lds_raw[];
    LAS unsigned char* lds = (LAS unsigned char*)lds_raw;
    unsigned char* ws = a.ws;
#define IN(k) true
#define SEAM(k) do { ++nbar; grid_bar((unsigned*)(ws + WS_CTL) + 1024, nbar * gridDim.x); } while (0)
    unsigned nbar = 0;
    if (IN(0)) { prologue(a, lds); }
    cg::this_grid().sync();
    for (int l = 0; l < DEPTH; ++l) {
        const int p0 = 1 + 4 * l;
        if (IN(p0)) {
            pg8::Gemm g{(const bf16_t*)(ws + WS_HN), (const bf16_t*)(ws + WS_WIN) + (size_t)l * NIN * DM, MROWS, NIN, DM};
            pg8::StaticOrder S; S.init(MROWS, NIN, (int)gridDim.x, (int)blockIdx.x);
            pg8::EpiStore<true> E{(bf16_t*)(ws + WS_PROJ), NIN, (const f32x2*)(ws + WS_ROPE)};
            pg8::gemm_phase<pg8::EpiStore<true>, pg8::StaticOrder, true, true>(lds, g, S, E);
        }
        SEAM(p0);
        if (IN(p0 + 1)) {
            att::attn_phase(lds, (const bf16_t*)(ws + WS_PROJ), (bf16_t*)(ws + WS_HN), (float*)(ws + WS_STASH), (unsigned*)(ws + WS_CTL) + 2048 + 512 * l, l == DEPTH - 1,
                            (const float*)(ws + WS_LAM) + 2 * l, a.in[12] + (size_t)l * 128, a.in[7] + (size_t)l * 8);
        }
        SEAM(p0 + 1);
        if (IN(p0 + 2)) {
            pg8::Gemm g{(const bf16_t*)(ws + WS_HN), (const bf16_t*)(ws + WS_WOUT) + (size_t)l * DM * DM, MROWS, DM, DM};
            pg8::StaticOrder S; S.init(MROWS, DM, (int)gridDim.x, (int)blockIdx.x);
            pg8::EpiStore<false> E{(bf16_t*)(ws + WS_PROJ), DM, nullptr};
            pg8::gemm_phase<pg8::EpiStore<false>, pg8::StaticOrder, true, true>(lds, g, S, E);
        }
        SEAM(p0 + 2);
        if (IN(p0 + 3)) norm_phase(a, l);
        SEAM(p0 + 3);
    }
#undef IN
#undef SEAM
}

extern "C" void kernel_launch(void* const* d_in, const int* in_sizes, int n_in, void* d_out, int out_size, void* d_ws, size_t ws_size, hipStream_t stream) {
    static int grid = 0;
    if (grid == 0) {
        if (n_in != 13 || ws_size < WS_END) { fprintf(stderr, "kernel_launch: need 13 inputs and >= %zu bytes of workspace; got %d, %zu\n", (size_t)WS_END, n_in, ws_size); grid = -1; return; }
        int dev = 0, cus = 0, per_cu = 0;
        if (hipGetDevice(&dev) != hipSuccess || hipDeviceGetAttribute(&cus, hipDeviceAttributeMultiprocessorCount, dev) != hipSuccess) { grid = -1; return; }
        if (hipFuncSetAttribute((const void*)fwd_kernel, hipFuncAttributeMaxDynamicSharedMemorySize, LDS_BYTES) != hipSuccess) { fprintf(stderr, "kernel_launch: hipFuncSetAttribute failed\n"); grid = -1; return; }
        if (hipOccupancyMaxActiveBlocksPerMultiprocessor(&per_cu, (const void*)fwd_kernel, NWAVES * 64, LDS_BYTES) != hipSuccess || per_cu < 1) { fprintf(stderr, "kernel_launch: occupancy query says %d\n", per_cu); per_cu = 1; }
        (void)hipGetLastError();
        grid = cus * 1;
    }
    if (grid < 0) return;
    (void)hipMemsetAsync((char*)d_ws + WS_CTL, 0, CTL_BYTES, stream);
    Args a{};
    for (int i = 0; i < 13; ++i) a.in[i] = (const float*)d_in[i];
    a.out = (float*)d_out; a.ws = (unsigned char*)d_ws; a.ph_lo = 0; a.ph_hi = N_PHASES;
    void* args[] = {&a};
    hipError_t e = hipLaunchCooperativeKernel((const void*)fwd_kernel, dim3(grid), dim3(NWAVES * 64), args, LDS_BYTES, stream);
    if (e != hipSuccess) fprintf(stderr, "cooperative launch failed: %s (grid %d)\n", hipGetErrorString(e), grid);
}
```

```cpp
#include <hip/hip_runtime.h>
#include <hip/hip_cooperative_groups.h>
#include <cstdio>
#include <cstdint>
namespace cg = cooperative_groups;

constexpr int DM = 1024, NIN = 3328, NB = 16, DEPTH = 4;
constexpr int LP = 4112, LS = 2064, SP = 4096, SS = 2048;
constexpr int ROWS_P = NB * LP, ROWS_S = NB * LS, MROWS = ROWS_P + ROWS_S;
constexpr float EPS = 1e-6f;
constexpr int C_AQ = 0, C_AK = 512, C_AV = 640, C_AG = 768, C_BQ = 1280, C_BK = 1792, C_BV = 2304, C_BG = 2816;

constexpr size_t MiB = 1u << 20;
constexpr size_t WS_CTL = 0, CTL_BYTES = 65536;
constexpr size_t WS_LAM = 1 * MiB;
constexpr size_t WS_ROPE = 2 * MiB;
constexpr size_t WS_WIN = 4 * MiB;
constexpr size_t WS_WOUT = 30 * MiB;
constexpr size_t WS_METAH = 38 * MiB;
constexpr size_t WS_STASH = 40 * MiB;
constexpr size_t WS_HN = 72 * MiB;
constexpr size_t WS_PROJ = 266 * MiB;
constexpr size_t WS_END = 894 * MiB;

#define LAS __attribute__((address_space(3)))
typedef unsigned short bf16_t;
typedef short bf16x8 __attribute__((ext_vector_type(8)));
typedef short s16x4 __attribute__((ext_vector_type(4)));
typedef float f32x2 __attribute__((ext_vector_type(2)));
typedef float f32x4 __attribute__((ext_vector_type(4)));
typedef float f32x16 __attribute__((ext_vector_type(16)));
typedef unsigned u32x2 __attribute__((ext_vector_type(2)));
typedef unsigned u32x4 __attribute__((ext_vector_type(4)));

__device__ __forceinline__ unsigned cvtpk(float lo, float hi) {
    typedef __bf16 b2 __attribute__((ext_vector_type(2)));
    f32x2 v = {lo, hi}; b2 b = __builtin_convertvector(v, b2); return __builtin_bit_cast(unsigned, b);
}
__device__ __forceinline__ float bf_lo(unsigned u) { return __uint_as_float(u << 16); }
__device__ __forceinline__ float bf_hi(unsigned u) { return __uint_as_float(u & 0xffff0000u); }
__device__ __forceinline__ float wave_sum(float v, int lane) {
#pragma unroll
    for (int o = 1; o < 64; o <<= 1) v += __int_as_float(__builtin_amdgcn_ds_bpermute((lane ^ o) << 2, __float_as_int(v)));
    return v;
}
__device__ __forceinline__ void row_decode(int row, int& g, int& b, int& pos) {
    if (row < ROWS_P) { g = 0; b = row / LP; pos = row - b * LP; }
    else { const int r = row - ROWS_P; g = 1; b = r / LS; pos = r - b * LS; }
}

namespace pg8 {
#define PG8_LAS __attribute__((address_space(3)))
constexpr int BM = 256, BK = 64, HALF = 128, HTB = HALF * BK * 2  , STAGE_BYTES = 8 * HTB, NXCD = 8, WGM = 8;

__host__ __device__ __forceinline__ int lds_byte(int r, int c) { const int st = (r >> 4) * 2 + (c >> 5), rr = r & 15, cc = c & 31, ob = rr * 64 + cc * 2; return st * 1024 + (ob ^ (((ob >> 9) & 1) << 5)); }
__host__ __device__ __forceinline__ void stage_rc(int b, int& R, int& C) { const int st = b / 1024, sb = b % 1024, swz = sb ^ (((sb >> 9) & 1) << 5); R = (st >> 1) * 16 + swz / 64; C = (st & 1) * 32 + (swz % 64) / 2; }
__host__ __device__ __forceinline__ int perm32(int rho) { const int n = rho >> 4, i = rho & 15; return 8 * (i >> 2) + 4 * n + (i & 3); }

struct Unit { int pm, pn; };
struct Gemm { const bf16_t* A; const bf16_t* Bt; int M, N, K; };

struct StaticOrder {
    int nM, nN, nwg, G, c;
    __host__ __device__ void init(int M, int N, int G_, int c_) { nM = M / BM; nN = N / BM; nwg = nM * nN; G = G_; c = c_; }
    __host__ __device__ bool next(int i, Unit& u) const {
        const long L = (long)i * G + c; if (L >= nwg) return false;
        int wgid = (int)L; { const int q = nwg / NXCD, r = nwg % NXCD, xcd = wgid % NXCD, off = wgid / NXCD; wgid = (xcd < r ? xcd * (q + 1) : r * (q + 1) + (xcd - r) * q) + off; }
        const int nig = WGM * nN, gid = wgid / nig, fm = gid * WGM, gsz = (nM - fm) < WGM ? (nM - fm) : WGM;
        u.pm = fm + ((wgid % nig) % gsz); u.pn = (wgid % nig) / gsz; return true;
    }
    __device__ __forceinline__ void a_ready(const Unit&) const {}
    __device__ __forceinline__ void done(const Unit&) const {}
};

template <bool ROPE> struct EpiStore {
    static constexpr bool PERM = true, AFTER_DRAIN = false;
    bf16_t* O; int ldc; const f32x2* rope;
    __device__ __forceinline__ void operator()(const f32x4 (&acc)[2][2][4][2], const Unit& u, int wr, int wc, int fr, int fq) const {
        const int row0 = u.pm * BM + wr * 64 + fr; const int col0 = u.pn * BM + wc * 32 + 8 * fq;
#pragma unroll
        for (int ai = 0; ai < 2; ++ai)
#pragma unroll
            for (int m = 0; m < 4; ++m) {
                const int row = row0 + ai * HALF + m * 16;
                bf16_t* rowp = O + (size_t)row * ldc + col0;
                int pos = 0;
                if (ROPE) { int g, b; row_decode(row, g, b, pos); }
#pragma unroll
                for (int bj = 0; bj < 2; ++bj) {
                    f32x4 v0 = acc[ai][bj][m][0], v1 = acc[ai][bj][m][1];
                    if (ROPE) {
                        const int half = 2 * u.pn + bj;
                        const bool dorope = (half < 5) || (half >= 10 && half < 18);
                        if (dorope) {
                            const int i0 = ((col0 + bj * HALF) & 63) >> 1;
                            const f32x4* rp = (const f32x4*)(rope + (size_t)pos * 32 + i0);
                            const f32x4 cs0 = rp[0], cs1 = rp[1];
                            f32x4 w0, w1;
                            w0[0] = (v0[0] * cs0[0] - v0[1] * cs0[1]); w0[1] = (v0[1] * cs0[0] + v0[0] * cs0[1]);
                            w0[2] = (v0[2] * cs0[2] - v0[3] * cs0[3]); w0[3] = (v0[3] * cs0[2] + v0[2] * cs0[3]);
                            w1[0] = (v1[0] * cs1[0] - v1[1] * cs1[1]); w1[1] = (v1[1] * cs1[0] + v1[0] * cs1[1]);
                            w1[2] = (v1[2] * cs1[2] - v1[3] * cs1[3]); w1[3] = (v1[3] * cs1[2] + v1[2] * cs1[3]);
                            v0 = w0; v1 = w1;
                        }
                    }
                    u32x4 w; w.x = cvtpk(v0[0], v0[1]); w.y = cvtpk(v0[2], v0[3]); w.z = cvtpk(v1[0], v1[1]); w.w = cvtpk(v1[2], v1[3]);
                    *(u32x4*)(rowp + bj * HALF) = w;
                }
            }
    }
};

template <class Epi, class Sched, bool ALIGN_EPI = false, bool SP2 = false>
__device__ __forceinline__ void gemm_phase(PG8_LAS unsigned char* lds, const Gemm g, const Sched& S, const Epi& E) {
    int tid_ = threadIdx.x; asm volatile("" : "+v"(tid_));
    const int tid = tid_, wid = __builtin_amdgcn_readfirstlane(tid >> 6), lane = tid & 63, wr = wid >> 2, wc = wid & 3, fr = lane & 15, fq = lane >> 4;
    const int K = g.K, nt = K / BK;
    unsigned voffA[2], voffB[2];
#pragma unroll
    for (int i = 0; i < 2; ++i) { int R, C; stage_rc(tid * 16 + i * 8192, R, C); const int Rb = Epi::PERM ? ((R & ~31) + perm32(R & 31)) : R;
        voffA[i] = (unsigned)(R * K + C) * 2u; voffB[i] = (unsigned)(Rb * K + C) * 2u; }
    const size_t kstep = (size_t)(BK * 2);
    const size_t hstep = (size_t)HALF * K * 2;
    const size_t tstep = 2 * hstep;
    const unsigned ldsw = (unsigned)wid * 1024u;
    const int aoff = lds_byte(wr * 64 + fr, fq * 8), boff = lds_byte(wc * 32 + fr, fq * 8);
#define PG8_SA(b, h) (((b) * 2 + (h)) * HTB)
#define PG8_SB(b, h) ((4 + (b) * 2 + (h)) * HTB)
#define PG8_STAGE(bufoff, gbase, voff) do { _Pragma("unroll") for (int _i = 0; _i < 2; ++_i) \
        __builtin_amdgcn_global_load_lds((const unsigned*)((const char*)(gbase) + (voff)[_i]), (PG8_LAS unsigned*)(lds + (bufoff) + ldsw + _i * 8192), 16, 0, 0); } while (0)
#define PG8_LDA(dst, b, h) do { _Pragma("unroll") for (int m = 0; m < 4; ++m) _Pragma("unroll") for (int k = 0; k < 2; ++k) dst[m][k] = *(const PG8_LAS bf16x8*)(lds + PG8_SA(b, h) + aoff + m * 2048 + k * 1024); } while (0)
#define PG8_LDB(dst, b, h) do { _Pragma("unroll") for (int n = 0; n < 2; ++n) _Pragma("unroll") for (int k = 0; k < 2; ++k) dst[n][k] = *(const PG8_LAS bf16x8*)(lds + PG8_SB(b, h) + boff + n * 2048 + k * 1024); } while (0)
#define PG8_MMA(ai, bj, At, Bt) do { __builtin_amdgcn_s_setprio(1); _Pragma("unroll") for (int m = 0; m < 4; ++m) _Pragma("unroll") for (int n = 0; n < 2; ++n) _Pragma("unroll") for (int k = 0; k < 2; ++k) \
        acc[ai][bj][m][n] = __builtin_amdgcn_mfma_f32_16x16x32_bf16(Bt[n][k], At[m][k], acc[ai][bj][m][n], 0, 0, 0); __builtin_amdgcn_s_setprio(0); } while (0)
#define PG8_WAIT_V(n) asm volatile("s_waitcnt vmcnt(" #n ")" ::: "memory")
#define PG8_WAIT_L(n) asm volatile("s_waitcnt lgkmcnt(" #n ")" ::: "memory")
#define PG8_BAR __builtin_amdgcn_s_barrier()
#define PG8_SCHED __builtin_amdgcn_sched_barrier(0)
    Unit cur, nxt; int ui = 0;
    (void)S.next(0, cur);
    f32x4 acc[2][2][4][2];
#pragma unroll
    for (int a = 0; a < 2; ++a)
#pragma unroll
        for (int b = 0; b < 2; ++b)
#pragma unroll
            for (int m = 0; m < 4; ++m)
#pragma unroll
                for (int n = 0; n < 2; ++n) acc[a][b][m][n] = (f32x4){0.f, 0.f, 0.f, 0.f};
    bf16x8 At[4][2], B0[2][2], B1[2][2];
    const char* cA = (const char*)g.A + (size_t)cur.pm * tstep; const char* cB = (const char*)g.Bt + (size_t)cur.pn * tstep;
    S.a_ready(cur);
    if constexpr (SP2) {
        PG8_STAGE(PG8_SB(0, 0), cB, voffB); PG8_STAGE(PG8_SB(0, 1), cB + hstep, voffB); PG8_STAGE(PG8_SA(0, 0), cA, voffA); PG8_STAGE(PG8_SA(0, 1), cA + hstep, voffA);
        if (wr == 1) PG8_BAR;
        PG8_WAIT_V(2); PG8_BAR;
        PG8_STAGE(PG8_SB(1, 0), cB + kstep, voffB); PG8_STAGE(PG8_SA(1, 0), cA + kstep, voffA); PG8_STAGE(PG8_SB(1, 1), cB + hstep + kstep, voffB);
        PG8_WAIT_V(6); PG8_BAR;
    } else {
        PG8_STAGE(PG8_SB(0, 0), cB, voffB); PG8_STAGE(PG8_SA(0, 0), cA, voffA); PG8_STAGE(PG8_SB(0, 1), cB + hstep, voffB); PG8_STAGE(PG8_SA(0, 1), cA + hstep, voffA);
        if (wr == 1) PG8_BAR;
        PG8_WAIT_V(4); PG8_BAR;
        PG8_STAGE(PG8_SB(1, 0), cB + kstep, voffB); PG8_STAGE(PG8_SA(1, 0), cA + kstep, voffA); PG8_STAGE(PG8_SB(1, 1), cB + hstep + kstep, voffB);
        PG8_WAIT_V(6); PG8_BAR;
    }
    for (;;) {
        const bool has_next = S.next(ui + 1, nxt);
        const char* nA = has_next ? (const char*)g.A + (size_t)nxt.pm * tstep : cA; const char* nB = has_next ? (const char*)g.Bt + (size_t)nxt.pn * tstep : cB;
        for (int t = 0; t < nt; t += 2) {
            const bool last = (t == nt - 2);
            const char* a1 = cA + (size_t)(t + 1) * kstep;
            const char* a2 = last ? nA : cA + (size_t)(t + 2) * kstep; const char* b2 = last ? nB : cB + (size_t)(t + 2) * kstep;
            const char* a3 = a2 + kstep; const char* b3 = b2 + kstep;
            if (last && has_next) S.a_ready(nxt);
            if constexpr (SP2) {
            PG8_LDB(B0, 0, 0); PG8_LDB(B1, 0, 1); PG8_SCHED; PG8_LDA(At, 0, 0); PG8_STAGE(PG8_SA(1, 1), a1 + hstep, voffA);
            PG8_WAIT_V(8); PG8_WAIT_L(0); PG8_BAR; PG8_MMA(0, 0, At, B0); PG8_MMA(0, 1, At, B1); PG8_BAR; PG8_SCHED;
            PG8_LDA(At, 0, 1); PG8_STAGE(PG8_SB(0, 0), b2, voffB); PG8_STAGE(PG8_SB(0, 1), b2 + hstep, voffB); PG8_STAGE(PG8_SA(0, 0), a2, voffA);
            PG8_WAIT_V(8); PG8_WAIT_L(0); PG8_BAR; PG8_MMA(1, 0, At, B0); PG8_MMA(1, 1, At, B1); PG8_BAR; PG8_SCHED;
            PG8_LDB(B0, 1, 0); PG8_LDB(B1, 1, 1); PG8_SCHED; PG8_LDA(At, 1, 0); PG8_STAGE(PG8_SA(0, 1), a2 + hstep, voffA);
            PG8_WAIT_V(8); PG8_WAIT_L(0); PG8_BAR; PG8_MMA(0, 0, At, B0); PG8_MMA(0, 1, At, B1); PG8_BAR; PG8_SCHED;
            PG8_LDA(At, 1, 1); PG8_STAGE(PG8_SB(1, 0), b3, voffB); PG8_STAGE(PG8_SB(1, 1), b3 + hstep, voffB); PG8_STAGE(PG8_SA(1, 0), a3, voffA);
            PG8_WAIT_V(8); PG8_WAIT_L(0); PG8_BAR; PG8_MMA(1, 0, At, B0); PG8_MMA(1, 1, At, B1); PG8_BAR; PG8_SCHED;
            } else {
            PG8_LDB(B0, 0, 0); PG8_SCHED; PG8_LDA(At, 0, 0); PG8_STAGE(PG8_SA(1, 1), a1 + hstep, voffA);
            PG8_WAIT_L(8); PG8_BAR; PG8_WAIT_L(0); PG8_MMA(0, 0, At, B0); PG8_BAR; PG8_SCHED;
            PG8_LDB(B1, 0, 1); PG8_STAGE(PG8_SB(0, 0), b2, voffB);
            PG8_BAR; PG8_WAIT_L(0); PG8_MMA(0, 1, At, B1); PG8_BAR;
            PG8_LDA(At, 0, 1); PG8_STAGE(PG8_SA(0, 0), a2, voffA);
            PG8_BAR; PG8_WAIT_L(0); PG8_MMA(1, 0, At, B0); PG8_BAR; PG8_SCHED;
            PG8_STAGE(PG8_SB(0, 1), b2 + hstep, voffB);
            PG8_WAIT_V(6); PG8_BAR; PG8_MMA(1, 1, At, B1); PG8_BAR;
            PG8_LDB(B0, 1, 0); PG8_SCHED; PG8_LDA(At, 1, 0); PG8_STAGE(PG8_SA(0, 1), a2 + hstep, voffA);
            PG8_WAIT_L(8); PG8_BAR; PG8_WAIT_L(0); PG8_MMA(0, 0, At, B0); PG8_BAR; PG8_SCHED;
            PG8_LDB(B1, 1, 1); PG8_STAGE(PG8_SB(1, 0), b3, voffB);
            PG8_BAR; PG8_WAIT_L(0); PG8_MMA(0, 1, At, B1); PG8_BAR;
            PG8_LDA(At, 1, 1); PG8_STAGE(PG8_SA(1, 0), a3, voffA);
            PG8_BAR; PG8_WAIT_L(0); PG8_MMA(1, 0, At, B0); PG8_BAR; PG8_SCHED;
            PG8_STAGE(PG8_SB(1, 1), b3 + hstep, voffB);
            PG8_WAIT_V(6); PG8_BAR; PG8_MMA(1, 1, At, B1); PG8_BAR;
            }
        }
        if constexpr (ALIGN_EPI) { if (wr == 0) PG8_BAR; }
        if constexpr (!Epi::AFTER_DRAIN) { E(acc, cur, wr, wc, fr, fq); S.done(cur); }
        if (!has_next) break;
#pragma unroll
        for (int a = 0; a < 2; ++a)
#pragma unroll
            for (int b = 0; b < 2; ++b)
#pragma unroll
                for (int m = 0; m < 4; ++m)
#pragma unroll
                    for (int n = 0; n < 2; ++n) acc[a][b][m][n] = (f32x4){0.f, 0.f, 0.f, 0.f};
        cur = nxt; cA = nA; cB = nB; ++ui;
        if constexpr (ALIGN_EPI) { if (wr == 1) PG8_BAR; }
    }
    PG8_WAIT_V(0);
    if constexpr (!ALIGN_EPI) { if (wr == 0) PG8_BAR; }
    PG8_BAR;
    if constexpr (Epi::AFTER_DRAIN) { E.fused(acc, cur, wr, wc, fr, fq, lds, wid, lane); S.done(cur); }
#undef PG8_SA
#undef PG8_SB
#undef PG8_STAGE
#undef PG8_LDA
#undef PG8_LDB
#undef PG8_MMA
#undef PG8_WAIT_V
#undef PG8_WAIT_L
#undef PG8_BAR
#undef PG8_SCHED
}
}

namespace att {
typedef short v4i16_t __attribute__((ext_vector_type(4)));
typedef LAS const unsigned char* lcp;
constexpr float NEG = -1.0e30f;
constexpr float LOG2E = 1.4426950408889634f;
constexpr int KP = 144, VP128 = 320, VP64 = 192;
constexpr int KBUF = 64 * KP, VBUF = 64 * VP128;
constexpr int SW_K = 0, SW_V = 24576;
constexpr int OFF_K0 = 0, OFF_K1 = KBUF, OFF_V0 = 2 * KBUF, OFF_V1 = 2 * KBUF + VBUF, OFF_UNIT = 131072;
enum { K_NONE = 0, K_DENSE = 1, K_META = 2, K_BAND = 3, K_METAQ = 4 };

__device__ __forceinline__ int crow(int i, int h) { return (i & 3) + 8 * (i >> 2) + 4 * h; }
__device__ __forceinline__ float swapmax(float v) { auto rr = __builtin_amdgcn_permlane32_swap(__float_as_uint(v), __float_as_uint(v), false, false); return fmaxf(__uint_as_float(rr[0]), __uint_as_float(rr[1])); }
__device__ __forceinline__ float swapsum(float v) { auto rr = __builtin_amdgcn_permlane32_swap(__float_as_uint(v), __float_as_uint(v), false, false); return __uint_as_float(rr[0]) + __uint_as_float(rr[1]); }
__device__ __forceinline__ s16x4 vtr(lcp p) { return __builtin_bit_cast(s16x4, __builtin_amdgcn_ds_read_tr16_b64_v4i16((LAS v4i16_t*)p)); }
__device__ __forceinline__ float max3f(float a, float b, float c) { float r; asm("v_max3_f32 %0, %1, %2, %3" : "=v"(r) : "v"(a), "v"(b), "v"(c)); return r; }
__device__ __forceinline__ float ex2(float x) { return __builtin_amdgcn_exp2f(x); }
__device__ __forceinline__ float silu(float x) { return x * __builtin_amdgcn_rcpf(1.0f + ex2(-x * LOG2E)); }

template <int KIND> __device__ __forceinline__ bool kvalid(int kr, int lim, int qi) {
    if (KIND == K_DENSE) return kr < lim;
    if (KIND == K_META) return kr < 16;
    if (KIND == K_BAND) { const int u = kr - 16; const int d = u - qi; return (unsigned)u < (unsigned)lim && d <= 128 && d >= -128; }
    if (KIND == K_METAQ) { const int u = kr - 16; return kr < 16 || (u < 128 && u <= 112 + qi); }
    return true;
}

template <int DV, int KIND>
__device__ __forceinline__ void tile_compute(f32x16 (&o)[DV / 32], float& m, float& l, const bf16x8 (&qf)[4], lcp kb, lcp vb, int r0, int h, int lim, int qi) {
    constexpr int VP = (DV == 128) ? VP128 : VP64;
    f32x16 s0, s1;
#pragma unroll
    for (int i = 0; i < 16; ++i) { s0[i] = 0.f; s1[i] = 0.f; }
#pragma unroll
    for (int ks = 0; ks < 4; ++ks) {
        const bf16x8 k0 = *(LAS const bf16x8*)(kb + ks * 32);
        const bf16x8 k1 = *(LAS const bf16x8*)(kb + 32 * KP + ks * 32);
        s0 = __builtin_amdgcn_mfma_f32_32x32x16_bf16(k0, qf[ks], s0, 0, 0, 0);
        s1 = __builtin_amdgcn_mfma_f32_32x32x16_bf16(k1, qf[ks], s1, 0, 0, 0);
        if (ks == 1) __builtin_amdgcn_sched_barrier(0);
    }
    if (KIND != K_NONE) {
        int hb = 4 * h + r0; asm volatile("" : "+v"(hb));
#pragma unroll
        for (int i = 0; i < 16; ++i) {
            const int kr = hb + (i & 3) + 8 * (i >> 2);
            s0[i] = kvalid<KIND>(kr, lim, qi) ? s0[i] : NEG;
            s1[i] = kvalid<KIND>(kr + 32, lim, qi) ? s1[i] : NEG;
        }
    }
    float mx = fmaxf(s0[0], s1[0]);
#pragma unroll
    for (int i = 1; i < 16; ++i) mx = fmaxf(mx, fmaxf(s0[i], s1[i]));
    mx = swapmax(mx);
    const float mn = fmaxf(m, mx);
    const float alpha = ex2(m - mn);
    m = mn;
    float rs = 0.f;
#pragma unroll
    for (int i = 0; i < 16; ++i) { s0[i] = ex2(s0[i] - mn); s1[i] = ex2(s1[i] - mn); rs += s0[i] + s1[i]; }
    l = l * alpha + rs;
#pragma unroll
    for (int c = 0; c < DV / 32; ++c)
#pragma unroll
        for (int i = 0; i < 16; ++i) o[c][i] *= alpha;
    bf16x8 pf[4];
    {
        u32x4 w;
        w.x = cvtpk(s0[0], s0[1]); w.y = cvtpk(s0[2], s0[3]); w.z = cvtpk(s0[4], s0[5]); w.w = cvtpk(s0[6], s0[7]); pf[0] = __builtin_bit_cast(bf16x8, w);
        w.x = cvtpk(s0[8], s0[9]); w.y = cvtpk(s0[10], s0[11]); w.z = cvtpk(s0[12], s0[13]); w.w = cvtpk(s0[14], s0[15]); pf[1] = __builtin_bit_cast(bf16x8, w);
        w.x = cvtpk(s1[0], s1[1]); w.y = cvtpk(s1[2], s1[3]); w.z = cvtpk(s1[4], s1[5]); w.w = cvtpk(s1[6], s1[7]); pf[2] = __builtin_bit_cast(bf16x8, w);
        w.x = cvtpk(s1[8], s1[9]); w.y = cvtpk(s1[10], s1[11]); w.z = cvtpk(s1[12], s1[13]); w.w = cvtpk(s1[14], s1[15]); pf[3] = __builtin_bit_cast(bf16x8, w);
    }
    constexpr int NC = DV / 32;
#pragma unroll
    for (int kk = 0; kk < 4; ++kk) {
        s16x4 alo[NC], ahi[NC];
#pragma unroll
        for (int c = 0; c < NC; ++c) { alo[c] = vtr(vb + (16 * kk) * VP + c * 64); ahi[c] = vtr(vb + (16 * kk + 8) * VP + c * 64); }
#pragma unroll
        for (int c = 0; c < NC; ++c) {
            const s16x4 lo = alo[c], hi = ahi[c];
            const bf16x8 a = {lo[0], lo[1], lo[2], lo[3], hi[0], hi[1], hi[2], hi[3]};
            o[c] = __builtin_amdgcn_mfma_f32_32x32x16_bf16(a, pf[kk], o[c], 0, 0, 0);
        }
        __builtin_amdgcn_sched_barrier(0);
    }
}

__device__ __forceinline__ bf16x8 pack8(const f32x16& s, int b) {
    u32x4 w; w.x = cvtpk(s[b], s[b + 1]); w.y = cvtpk(s[b + 2], s[b + 3]); w.z = cvtpk(s[b + 4], s[b + 5]); w.w = cvtpk(s[b + 6], s[b + 7]); return __builtin_bit_cast(bf16x8, w);
}
__device__ __forceinline__ void exp_pv_sw(f32x16 (&o)[4], float m, float& l, f32x16& s0, f32x16& s1, lcp vl, int vB0, int vB1, int q4) {
    const lcp vb0[4] = {vl + vB0 + ((0 ^ q4) << 6), vl + vB0 + ((1 ^ q4) << 6), vl + vB0 + ((2 ^ q4) << 6), vl + vB0 + ((3 ^ q4) << 6)};
    const lcp vb1[4] = {vl + vB1 + ((0 ^ q4) << 6), vl + vB1 + ((1 ^ q4) << 6), vl + vB1 + ((2 ^ q4) << 6), vl + vB1 + ((3 ^ q4) << 6)};
    s16x4 alo[2][4], ahi[2][4];
#define VLOAD(kk, b) do { _Pragma("unroll") for (int c = 0; c < 4; ++c) { alo[b][c] = vtr(vb0[c] + 4096 * (kk)); ahi[b][c] = vtr(vb1[c] + 4096 * (kk)); } } while (0)
#define PVMMA(b, P) do { _Pragma("unroll") for (int c = 0; c < 4; ++c) { const s16x4 lo = alo[b][c], hi = ahi[b][c]; const bf16x8 a = {lo[0], lo[1], lo[2], lo[3], hi[0], hi[1], hi[2], hi[3]}; \
            o[c] = __builtin_amdgcn_mfma_f32_32x32x16_bf16(a, (P), o[c], 0, 0, 0); } } while (0)
#define EXP8(S, b0) do { _Pragma("unroll") for (int i = (b0); i < (b0) + 8; ++i) { S[i] = ex2(S[i]); rs += S[i]; } } while (0)
    float rs = 0.f;
    VLOAD(0, 0);
    EXP8(s0, 0); const bf16x8 p0 = pack8(s0, 0);
    __builtin_amdgcn_sched_barrier(0);
    VLOAD(1, 1); PVMMA(0, p0);
    EXP8(s0, 8); const bf16x8 p1 = pack8(s0, 8);
    __builtin_amdgcn_sched_barrier(0);
    VLOAD(2, 0); PVMMA(1, p1);
    EXP8(s1, 0); const bf16x8 p2 = pack8(s1, 0);
    __builtin_amdgcn_sched_barrier(0);
    VLOAD(3, 1); PVMMA(0, p2);
    EXP8(s1, 8); const bf16x8 p3 = pack8(s1, 8);
    __builtin_amdgcn_sched_barrier(0);
    PVMMA(1, p3);
    l += rs;
    __builtin_amdgcn_sched_barrier(0);
#undef VLOAD
#undef PVMMA
#undef EXP8
}
__device__ __forceinline__ void tile_sw(f32x16 (&o)[4], float& m, float& l, f32x16& negm, const bf16x8 (&qf)[4], lcp kb, int kx, lcp vl, int vB0, int vB1, int q4, int r0, int h, int lim, bool masked, bool first) {
    f32x16 s0, s1;
    bf16x8 kf[4][2];
#pragma unroll
    for (int ks = 0; ks < 4; ++ks) { kf[ks][0] = *(LAS const bf16x8*)(kb + (kx ^ (ks << 5))); kf[ks][1] = *(LAS const bf16x8*)(kb + (kx ^ (ks << 5)) + 4096); }
    __builtin_amdgcn_sched_barrier(0);
#pragma unroll
    for (int ks = 0; ks < 4; ++ks) {
        if (ks == 0) { s0 = __builtin_amdgcn_mfma_f32_32x32x16_bf16(kf[0][0], qf[0], negm, 0, 0, 0); s1 = __builtin_amdgcn_mfma_f32_32x32x16_bf16(kf[0][1], qf[0], negm, 0, 0, 0); }
        else { s0 = __builtin_amdgcn_mfma_f32_32x32x16_bf16(kf[ks][0], qf[ks], s0, 0, 0, 0); s1 = __builtin_amdgcn_mfma_f32_32x32x16_bf16(kf[ks][1], qf[ks], s1, 0, 0, 0); }
    }
    if (masked) {
        int hb = 4 * h + r0; asm volatile("" : "+v"(hb));
#pragma unroll
        for (int i = 0; i < 16; ++i) {
            const int kr = hb + (i & 3) + 8 * (i >> 2);
            s0[i] = kr < lim ? s0[i] : NEG;
            s1[i] = kr + 32 < lim ? s1[i] : NEG;
        }
    }
    asm volatile("s_nop 15" : "+v"(s0), "+v"(s1));
    float mxa = max3f(s0[0], s0[1], s1[0]), mxb = max3f(s0[2], s0[3], s1[1]);
    mxa = max3f(mxa, s1[2], s1[3]);
#pragma unroll
    for (int i = 4; i < 16; i += 4) { mxa = max3f(mxa, s0[i], s0[i + 1]); mxb = max3f(mxb, s0[i + 2], s0[i + 3]); mxa = max3f(mxa, s1[i], s1[i + 1]); mxb = max3f(mxb, s1[i + 2], s1[i + 3]); }
    float mx = max3f(mxa, mxb, mxb);
    mx = swapmax(mx);
    if (first || __builtin_amdgcn_ballot_w64(mx > 8.0f) != 0ull) {
        const float delta = first ? mx : fmaxf(mx, 0.f);
        const float alpha = first ? 1.0f : ex2(-delta);
        m += delta; l *= alpha;
#pragma unroll
        for (int c = 0; c < 4; ++c)
#pragma unroll
            for (int i = 0; i < 16; ++i) asm volatile("v_mul_f32 %0, %1, %0" : "+v"(o[c][i]) : "v"(alpha));
#pragma unroll
        for (int i = 0; i < 16; ++i) { s0[i] -= delta; s1[i] -= delta; negm[i] = -m; }
    }
    exp_pv_sw(o, m, l, s0, s1, vl, vB0, vB1, q4);
}

__device__ __forceinline__ void glds16(const void* gsrc, unsigned lds_dst) {
    unsigned keep;
    asm volatile("s_mov_b32 %0, m0\n\ts_mov_b32 m0, %2\n\ts_nop 0\n\tglobal_load_lds_dwordx4 %1, off\n\ts_mov_b32 m0, %0" : "=&s"(keep) : "v"(gsrc), "s"(lds_dst) : "memory");
}
__device__ __forceinline__ int clampi(int v, int lo, int hi) { return v < lo ? lo : (v > hi ? hi : v); }

__device__ __forceinline__ void diff_unit(LAS unsigned char* lds, const bf16_t* __restrict__ proj, bf16_t* __restrict__ aout, float* __restrict__ stash,
                                          int g, int b, int hh, int qb, const float* __restrict__ lamp, const float* __restrict__ subg) {
    int tid_ = threadIdx.x; asm volatile("" : "+v"(tid_));
    const int tid = tid_, lane = tid & 63, r32 = lane & 31, h = lane >> 5;
    const int w = __builtin_amdgcn_readfirstlane(tid >> 6);
    const int L = g ? LS : LP, brow0 = g ? ROWS_P + b * LS : b * LP, NT = (L + 63) >> 6;
    const bool active = (qb >= 0) || (w == 0);
    const int qrow = (qb >= 0) ? 16 + 256 * qb + 32 * w + r32 : r32;
    const bool rowvalid = (qb >= 0) || (r32 < 16);
    const int kkey = 8 * w + (lane >> 3), kchunk = (lane & 7) ^ ((kkey >> 1) & 7);
    const int vkey0 = 8 * w + (lane >> 4), vkey1 = vkey0 + 4;
    const int vchunk0 = (lane & 15) ^ (((vkey0 & 3) << 2) | ((vkey0 >> 2) & 3)), vchunk1 = (lane & 15) ^ (((vkey1 & 3) << 2) | ((vkey1 >> 2) & 3));
    const bf16_t* kbase = proj + (size_t)brow0 * NIN + C_BK + hh * 128 + kchunk * 8;
    const bf16_t* vbase0 = proj + (size_t)brow0 * NIN + C_BV + hh * 128 + vchunk0 * 8;
    const bf16_t* vbase1 = proj + (size_t)brow0 * NIN + C_BV + hh * 128 + vchunk1 * 8;
    const int fsw = (r32 >> 1) & 7;
    const lcp kb = (lcp)lds + r32 * 128 + ((h ^ (fsw & 1)) * 16);
    const int kx = (fsw >> 1) << 5;
    const int q4 = (lane & 15) >> 2, blk = (lane >> 4) & 1, p4 = lane & 3;
    const int vB0 = (4 * h + q4) * 256 + (((2 * blk + (p4 >> 1)) ^ h) * 16) + 8 * (p4 & 1);
    const int vB1 = (vB0 ^ 32) + 2048;

    f32x16 o[4]; float m = 0.f, l = 0.f; bf16x8 qf[4]; f32x16 negm;
#pragma unroll
    for (int i = 0; i < 16; ++i) negm[i] = 0.f;
#pragma unroll
    for (int c = 0; c < 4; ++c)
#pragma unroll
        for (int i = 0; i < 16; ++i) o[c][i] = 0.f;
    const int total = 2 * NT;
    const unsigned ldsw_k = (unsigned)w * 1024u, ldsw_v = (unsigned)w * 2048u;
    const unsigned lds0 = (unsigned)(size_t)lds;
    const bf16_t* kp = kbase + (size_t)kkey * NIN; const bf16_t* vp0 = vbase0 + (size_t)vkey0 * NIN; const bf16_t* vp1 = vbase1 + (size_t)vkey1 * NIN;
#define DIFF_DMA(tn, kslot, vslot) do { \
        glds16(kp, (unsigned)__builtin_amdgcn_readfirstlane(lds0 + SW_K + (kslot) * 8192 + ldsw_k)); \
        glds16(vp0, (unsigned)__builtin_amdgcn_readfirstlane(lds0 + SW_V + (vslot) * 16384 + ldsw_v)); \
        glds16(vp1, (unsigned)__builtin_amdgcn_readfirstlane(lds0 + SW_V + (vslot) * 16384 + ldsw_v + 1024u)); \
        { const bool wrap_ = ((tn) + 1 == NT);                   \
          const long dk_ = wrap_ ? (long)64 - (long)(NT - 1) * 64 * NIN : (long)64 * NIN, dv_ = wrap_ ? -(long)(NT - 1) * 64 * NIN : (long)64 * NIN; \
          kp += dk_; vp0 += dv_; vp1 += dv_; } } while (0)
    DIFF_DMA(0, 0, 0); DIFF_DMA(1, 1, 1);
    asm volatile("s_waitcnt vmcnt(3)" ::: "memory");
    __builtin_amdgcn_s_barrier(); asm volatile("" ::: "memory");
    int k_cur = 0, k_nn = 2, v_cur = 0, v_nn = 2;
    for (int t = 0; t < total; ++t) {
        const int c = t >= NT ? 1 : 0, tt = t - c * NT;
        if (tt == 0) {
            if (c == 1 && active) {
                const float inv = __builtin_amdgcn_rcpf(swapsum(l));
                int td = tid; asm volatile("" : "+v"(td));
                float* sp = stash + ((size_t)blockIdx.x * 512 + (td & ~63)) * 64 + (td & 63) * 4;
#pragma unroll
                for (int cc = 0; cc < 4; ++cc)
#pragma unroll
                    for (int g4 = 0; g4 < 4; ++g4) {
                        f32x4 v = {o[cc][4 * g4] * inv, o[cc][4 * g4 + 1] * inv, o[cc][4 * g4 + 2] * inv, o[cc][4 * g4 + 3] * inv};
                        *(f32x4*)(sp + (cc * 4 + g4) * 256) = v;
                        o[cc][4 * g4] = 0.f; o[cc][4 * g4 + 1] = 0.f; o[cc][4 * g4 + 2] = 0.f; o[cc][4 * g4 + 3] = 0.f;
                    }
                m = 0.f; l = 0.f;
#pragma unroll
                for (int i = 0; i < 16; ++i) negm[i] = 0.f;
            }
            int qr = qrow; asm volatile("" : "+v"(qr));
            const bf16_t* qp = proj + (size_t)(brow0 + qr) * NIN + C_BQ + hh * 128 + h * 8 + c * 64;
#pragma unroll
            for (int ks = 0; ks < 4; ++ks) qf[ks] = *(const bf16x8*)(qp + ks * 16);
            asm volatile("" : "+v"(qf[0]), "+v"(qf[1]), "+v"(qf[2]), "+v"(qf[3]) :: "memory");
        }
        if (t + 2 < total) DIFF_DMA(t + 2, k_nn, v_nn);
        if (active) {
            const int bo_k = SW_K + k_cur * 8192;
            const lcp vl = (lcp)lds + SW_V + v_cur * 16384;
            tile_sw(o, m, l, negm, qf, kb + bo_k, kx, vl, vB0, vB1, q4, 64 * tt, h, L, tt == NT - 1, tt == 0);
        }
        if (t + 2 < total) asm volatile("s_waitcnt vmcnt(3)" ::: "memory"); else asm volatile("s_waitcnt vmcnt(0)" ::: "memory");
        __builtin_amdgcn_s_barrier(); asm volatile("" ::: "memory");
        k_cur = (k_cur == 2) ? 0 : k_cur + 1; k_nn = (k_nn == 2) ? 0 : k_nn + 1;
        v_cur = (v_cur + 1) & 3; v_nn = (v_nn + 1) & 3;
    }
#undef DIFF_DMA
    if (active) {
        int td = tid, qr = qrow; asm volatile("" : "+v"(td), "+v"(qr));
        const float lam = lamp[0], oml = lamp[1];
        const float inv = __builtin_amdgcn_rcpf(swapsum(l)) * lam;
        const float* sp = stash + ((size_t)blockIdx.x * 512 + (td & ~63)) * 64 + (td & 63) * 4;
        float ss = 0.f;
#pragma unroll
        for (int cc = 0; cc < 4; ++cc)
#pragma unroll
            for (int g4 = 0; g4 < 4; ++g4) {
                const f32x4 sv = *(const f32x4*)(sp + (cc * 4 + g4) * 256);
#pragma unroll
                for (int e = 0; e < 4; ++e) { const float v = sv[e] - o[cc][4 * g4 + e] * inv; o[cc][4 * g4 + e] = v; ss += v * v; }
                if (g4 == 3) __builtin_amdgcn_sched_barrier(0);
            }
        ss = swapsum(ss);
        const float rstd = __builtin_amdgcn_rsqf(ss * (1.0f / 128.0f) + EPS) * oml;
        if (rowvalid) {
            const bf16_t* gp = proj + (size_t)(brow0 + qr) * NIN + C_BG + hh * 128;
            bf16_t* op = aout + (size_t)(brow0 + qr) * DM + 512 + hh * 128;
#pragma unroll
            for (int cc = 0; cc < 4; ++cc)
#pragma unroll
                for (int k2 = 0; k2 < 2; ++k2) {
                    float x[4], y[4];
#pragma unroll
                    for (int e = 0; e < 4; ++e) {
                        auto rr = __builtin_amdgcn_permlane32_swap(__float_as_uint(o[cc][8 * k2 + e]), __float_as_uint(o[cc][8 * k2 + 4 + e]), false, false);
                        x[e] = __uint_as_float(rr[0]); y[e] = __uint_as_float(rr[1]);
                    }
                    const int d = 32 * cc + 16 * k2 + 8 * h;
                    const u32x4 gt = *(const u32x4*)(gp + d);
                    const f32x4 sg0 = *(const f32x4*)(subg + d), sg1 = *(const f32x4*)(subg + d + 4);
                    const float v0 = x[0] * rstd * sg0[0] * silu(bf_lo(gt.x));
                    const float v1 = x[1] * rstd * sg0[1] * silu(bf_hi(gt.x));
                    const float v2 = x[2] * rstd * sg0[2] * silu(bf_lo(gt.y));
                    const float v3 = x[3] * rstd * sg0[3] * silu(bf_hi(gt.y));
                    const float v4 = y[0] * rstd * sg1[0] * silu(bf_lo(gt.z));
                    const float v5 = y[1] * rstd * sg1[1] * silu(bf_hi(gt.z));
                    const float v6 = y[2] * rstd * sg1[2] * silu(bf_lo(gt.w));
                    const float v7 = y[3] * rstd * sg1[3] * silu(bf_hi(gt.w));
                    u32x4 ov; ov.x = cvtpk(v0, v1); ov.y = cvtpk(v2, v3); ov.z = cvtpk(v4, v5); ov.w = cvtpk(v6, v7);
                    *(u32x4*)(op + d) = ov;
                    __builtin_amdgcn_sched_barrier(0);
                }
        }
    }
}

constexpr int WK = 0, WV = 49152;
enum { M_NONE = 0, M_META = 1, M_BAND = 2, M_METAQ = 3 };
__device__ __forceinline__ void wait_vm(int n) {
    switch (n) {
        case 0: asm volatile("s_waitcnt vmcnt(0)" ::: "memory"); break;
        case 2: asm volatile("s_waitcnt vmcnt(2)" ::: "memory"); break;
        case 4: asm volatile("s_waitcnt vmcnt(4)" ::: "memory"); break;
        case 6: asm volatile("s_waitcnt vmcnt(6)" ::: "memory"); break;
        case 8: asm volatile("s_waitcnt vmcnt(8)" ::: "memory"); break;
        default: asm volatile("s_waitcnt vmcnt(10)" ::: "memory"); break;
    }
}
__device__ __forceinline__ void tile_win(f32x16 (&o)[2], float& m, float& l, f32x16& negm, const bf16x8 (&qf)[4], lcp kb, int kx, lcp vl, int vB0, int q1, int r0, int h, int S, int qi, int kind, bool first) {
    f32x16 s0, s1;
    bf16x8 kf[4][2];
#pragma unroll
    for (int ks = 0; ks < 4; ++ks) { kf[ks][0] = *(LAS const bf16x8*)(kb + (kx ^ (ks << 5))); kf[ks][1] = *(LAS const bf16x8*)(kb + (kx ^ (ks << 5)) + 4096); }
    __builtin_amdgcn_sched_barrier(0);
#pragma unroll
    for (int ks = 0; ks < 4; ++ks) {
        if (ks == 0) { s0 = __builtin_amdgcn_mfma_f32_32x32x16_bf16(kf[0][0], qf[0], negm, 0, 0, 0); s1 = __builtin_amdgcn_mfma_f32_32x32x16_bf16(kf[0][1], qf[0], negm, 0, 0, 0); }
        else { s0 = __builtin_amdgcn_mfma_f32_32x32x16_bf16(kf[ks][0], qf[ks], s0, 0, 0, 0); s1 = __builtin_amdgcn_mfma_f32_32x32x16_bf16(kf[ks][1], qf[ks], s1, 0, 0, 0); }
    }
    if (kind != M_NONE) {
        int hb = 4 * h + r0; asm volatile("" : "+v"(hb));
        if (kind == M_META) {
#pragma unroll
            for (int i = 0; i < 16; ++i) { const int kr = hb + (i & 3) + 8 * (i >> 2); s0[i] = kvalid<K_META>(kr, S, qi) ? s0[i] : NEG; s1[i] = kvalid<K_META>(kr + 32, S, qi) ? s1[i] : NEG; }
        } else if (kind == M_BAND) {
#pragma unroll
            for (int i = 0; i < 16; ++i) { const int kr = hb + (i & 3) + 8 * (i >> 2); s0[i] = kvalid<K_BAND>(kr, S, qi) ? s0[i] : NEG; s1[i] = kvalid<K_BAND>(kr + 32, S, qi) ? s1[i] : NEG; }
        } else {
#pragma unroll
            for (int i = 0; i < 16; ++i) { const int kr = hb + (i & 3) + 8 * (i >> 2); s0[i] = kvalid<K_METAQ>(kr, S, qi) ? s0[i] : NEG; s1[i] = kvalid<K_METAQ>(kr + 32, S, qi) ? s1[i] : NEG; }
        }
    }
    asm volatile("s_nop 15" : "+v"(s0), "+v"(s1));
    float mxa = max3f(s0[0], s0[1], s1[0]), mxb = max3f(s0[2], s0[3], s1[1]);
    mxa = max3f(mxa, s1[2], s1[3]);
#pragma unroll
    for (int i = 4; i < 16; i += 4) { mxa = max3f(mxa, s0[i], s0[i + 1]); mxb = max3f(mxb, s0[i + 2], s0[i + 3]); mxa = max3f(mxa, s1[i], s1[i + 1]); mxb = max3f(mxb, s1[i + 2], s1[i + 3]); }
    float mx = max3f(mxa, mxb, mxb);
    mx = swapmax(mx);
    if (first || __builtin_amdgcn_ballot_w64(mx > 8.0f) != 0ull) {
        const float delta = first ? mx : fmaxf(mx, 0.f);
        const float alpha = first ? 1.0f : ex2(-delta);
        m += delta; l *= alpha;
#pragma unroll
        for (int c = 0; c < 2; ++c)
#pragma unroll
            for (int i = 0; i < 16; ++i) asm volatile("v_mul_f32 %0, %1, %0" : "+v"(o[c][i]) : "v"(alpha));
#pragma unroll
        for (int i = 0; i < 16; ++i) { s0[i] -= delta; s1[i] -= delta; negm[i] = -m; }
    }
    const lcp vb0[2] = {vl + vB0 + ((0 ^ q1) << 6), vl + vB0 + ((1 ^ q1) << 6)};
    s16x4 alo[2][2], ahi[2][2];
#define VLOAD(kk, b) do { _Pragma("unroll") for (int c = 0; c < 2; ++c) { alo[b][c] = vtr(vb0[c] + 2048 * (kk)); ahi[b][c] = vtr(vb0[c] + 2048 * (kk) + 1024); } } while (0)
#define PVMMA(b, P) do { _Pragma("unroll") for (int c = 0; c < 2; ++c) { const s16x4 lo = alo[b][c], hi = ahi[b][c]; const bf16x8 a = {lo[0], lo[1], lo[2], lo[3], hi[0], hi[1], hi[2], hi[3]}; \
            o[c] = __builtin_amdgcn_mfma_f32_32x32x16_bf16(a, (P), o[c], 0, 0, 0); } } while (0)
#define EXP8(S_, b0) do { _Pragma("unroll") for (int i = (b0); i < (b0) + 8; ++i) { S_[i] = ex2(S_[i]); rs += S_[i]; } } while (0)
    float rs = 0.f;
    VLOAD(0, 0);
    EXP8(s0, 0); const bf16x8 p0 = pack8(s0, 0);
    __builtin_amdgcn_sched_barrier(0);
    VLOAD(1, 1); PVMMA(0, p0);
    EXP8(s0, 8); const bf16x8 p1 = pack8(s0, 8);
    __builtin_amdgcn_sched_barrier(0);
    VLOAD(2, 0); PVMMA(1, p1);
    EXP8(s1, 0); const bf16x8 p2 = pack8(s1, 0);
    __builtin_amdgcn_sched_barrier(0);
    VLOAD(3, 1); PVMMA(0, p2);
    EXP8(s1, 8); const bf16x8 p3 = pack8(s1, 8);
    __builtin_amdgcn_sched_barrier(0);
    PVMMA(1, p3);
    l += rs;
    __builtin_amdgcn_sched_barrier(0);
#undef VLOAD
#undef PVMMA
#undef EXP8
}
__device__ __forceinline__ void win_unit(LAS unsigned char* lds, const bf16_t* __restrict__ proj, bf16_t* __restrict__ aout,
                                         int g, int b, int kh, int qb, const float* __restrict__ sink) {
    int tid_ = threadIdx.x; asm volatile("" : "+v"(tid_));
    const int tid = tid_, lane = tid & 63, r32 = lane & 31, h = lane >> 5;
    const int w = __builtin_amdgcn_readfirstlane(tid >> 6);
    const int L = g ? LS : LP, S = g ? SS : SP, brow0 = g ? ROWS_P + b * LS : b * LP;
    const bool real = qb >= 0;
    const bool active = real || (w < 2);
    const int ntile = real ? 6 : 3;
    const int hq = real ? 4 * kh + (w & 3) : 4 * kh + 2 * (w & 1) + (r32 >> 4);
    const int qi = real ? 64 * qb + 32 * (w >> 2) + r32 : (r32 & 15);
    const int qrow = real ? 16 + qi : qi;
    const int band0 = 16 + 64 * qb - 128;
    const int kkey = 8 * w + (lane >> 3), kchunk = (lane & 7) ^ ((kkey >> 1) & 7), vchunk = (lane & 7) ^ (((kkey >> 1) & 1) << 2);
    const bf16_t* kbase = proj + (size_t)brow0 * NIN + C_AK + kh * 64 + kchunk * 8;
    const bf16_t* vbase = proj + (size_t)brow0 * NIN + C_AV + kh * 64 + vchunk * 8;
    const int fsw = (r32 >> 1) & 7;
    const lcp kb = (lcp)lds + WK + r32 * 128 + ((h ^ (fsw & 1)) * 16);
    const int kx = (fsw >> 1) << 5;
    const int q4 = (lane & 15) >> 2, blk = (lane >> 4) & 1, p4 = lane & 3;
    const int vB0 = (4 * h + q4) * 128 + (2 * blk + (p4 >> 1)) * 16 + 8 * (p4 & 1);
    const unsigned lds0 = (unsigned)(size_t)lds;

    f32x16 o[2]; float m = 0.f, l = 0.f; bf16x8 qf[4]; f32x16 negm;
#pragma unroll
    for (int i = 0; i < 16; ++i) { o[0][i] = 0.f; o[1][i] = 0.f; negm[i] = 0.f; }
    {
        const bf16_t* qptr = proj + (size_t)(brow0 + qrow) * NIN + C_AQ + hq * 64 + h * 8;
#pragma unroll
        for (int ks = 0; ks < 4; ++ks) qf[ks] = *(const bf16x8*)(qptr + ks * 16);
        asm volatile("" : "+v"(qf[0]), "+v"(qf[1]), "+v"(qf[2]), "+v"(qf[3]) :: "memory");
    }
#define WIN_R0(t) (real ? ((t) == 0 ? 0 : band0 + 64 * ((t) - 1)) : 64 * (t))
    for (int t = 0; t < ntile; ++t) {
        const size_t ro = (size_t)clampi(WIN_R0(t) + kkey, 0, L - 1) * NIN;
        glds16(kbase + ro, (unsigned)__builtin_amdgcn_readfirstlane(lds0 + WK + t * 8192 + w * 1024));
        glds16(vbase + ro, (unsigned)__builtin_amdgcn_readfirstlane(lds0 + WV + t * 8192 + w * 1024));
    }
    for (int t = 0; t < ntile; ++t) {
        wait_vm(2 * (ntile - 1 - t));
        __builtin_amdgcn_s_barrier(); asm volatile("" ::: "memory");
        if (active) {
            const int r0 = WIN_R0(t);
            int kind;
            if (!real) kind = M_METAQ;
            else if (t == 0) kind = M_META;
            else {
                const int u0 = r0 - 16, q0 = 64 * qb;
                kind = (u0 >= 0 && u0 + 63 < S && u0 + 63 - q0 <= 128 && q0 + 63 - u0 <= 128) ? M_NONE : M_BAND;
            }
            tile_win(o, m, l, negm, qf, kb + t * 8192, kx, (lcp)lds + WV + t * 8192, vB0, q4 >> 1, r0, h, S, qi, kind, t == 0);
        }
    }
#undef WIN_R0
    __builtin_amdgcn_s_barrier(); asm volatile("" ::: "memory");
    if (active) {
        int qr = qrow; asm volatile("" : "+v"(qr));
        const float lt = swapsum(l) + ex2(sink[hq] * LOG2E - m);
        const float inv = __builtin_amdgcn_rcpf(lt);
        const bf16_t* gp = proj + (size_t)(brow0 + qr) * NIN + C_AG + hq * 64;
        bf16_t* op = aout + (size_t)(brow0 + qr) * DM + hq * 64;
#pragma unroll
        for (int cc = 0; cc < 2; ++cc)
#pragma unroll
            for (int k2 = 0; k2 < 2; ++k2) {
                float x[4], y[4];
#pragma unroll
                for (int e = 0; e < 4; ++e) {
                    auto rr = __builtin_amdgcn_permlane32_swap(__float_as_uint(o[cc][8 * k2 + e]), __float_as_uint(o[cc][8 * k2 + 4 + e]), false, false);
                    x[e] = __uint_as_float(rr[0]); y[e] = __uint_as_float(rr[1]);
                }
                const int d = 32 * cc + 16 * k2 + 8 * h;
                const u32x4 gt = *(const u32x4*)(gp + d);
                const float v0 = x[0] * inv * silu(bf_lo(gt.x));
                const float v1 = x[1] * inv * silu(bf_hi(gt.x));
                const float v2 = x[2] * inv * silu(bf_lo(gt.y));
                const float v3 = x[3] * inv * silu(bf_hi(gt.y));
                const float v4 = y[0] * inv * silu(bf_lo(gt.z));
                const float v5 = y[1] * inv * silu(bf_hi(gt.z));
                const float v6 = y[2] * inv * silu(bf_lo(gt.w));
                const float v7 = y[3] * inv * silu(bf_hi(gt.w));
                u32x4 ov; ov.x = cvtpk(v0, v1); ov.y = cvtpk(v2, v3); ov.z = cvtpk(v4, v5); ov.w = cvtpk(v6, v7);
                *(u32x4*)(op + d) = ov;
            }
    }
}

__device__ __forceinline__ void attn_phase(LAS unsigned char* lds, const bf16_t* proj, bf16_t* aout, float* stash, unsigned* ctr, bool last,
                                           const float* lamp, const float* subg, const float* sink) {
    const int nP = last ? 16 : 17, nS = last ? 8 : 9;
    const int e1 = 8 * nP, e2 = e1 + 8 * nS, e3 = e2 + 256, e4 = e3 + 128, e5 = e4 + (last ? 0 : 8);
    LAS volatile int* su = (LAS volatile int*)(lds + OFF_UNIT);
    const int xcd = (int)(__builtin_amdgcn_s_getreg((3 << 11) | 20) & 7u);
    int kq = 0;
    for (;;) {
        if (threadIdx.x == 0) {
            int u = -1, x = 0;
            while (kq < 8) {
                x = (xcd + kq) & 7;
                int z; asm volatile("v_mov_b32 %0, 0" : "=v"(z));
                const int v = (int)__hip_atomic_fetch_add(ctr + 16 * x + z, 1u, __ATOMIC_RELAXED, __HIP_MEMORY_SCOPE_AGENT);
                if (v < e5) { u = v; break; }
                ++kq;
            }
            su[0] = u; su[1] = x;
        }
        __syncthreads();
        const int u = su[0], x = su[1];
        __syncthreads();
        if (u < 0) break;
        if (u < e2) {
            int g, bh, qb;
            if (u < e1) { const int j = u / nP, r = u - j * nP; g = 0; bh = x + 8 * j; qb = r < 16 ? r : -1; }
            else { const int v = u - e1, j = v / nS, r = v - j * nS; g = 1; bh = x + 8 * j; qb = r < 8 ? r : -1; }
            diff_unit(lds, proj, aout, stash, g, bh >> 2, bh & 3, qb, lamp, subg);
        } else {
            int g, bk, qb;
            if (u < e3) { const int v = u - e2; g = 0; bk = x + 8 * (v >> 6); qb = v & 63; }
            else if (u < e4) { const int v = u - e3; g = 1; bk = x + 8 * (v >> 5); qb = v & 31; }
            else { const int v = u - e4; g = v >> 2; bk = x + 8 * (v & 3); qb = -1; }
            win_unit(lds, proj, aout, g, bk >> 1, bk & 1, qb, sink);
        }
    }
}
}

constexpr int NWAVES = 8;
constexpr int LDS_BYTES = 147456;
constexpr int N_PHASES = 1 + 4 * DEPTH;

__device__ __forceinline__ void grid_bar(unsigned* cnt, unsigned target) {
    asm volatile("s_waitcnt vmcnt(0)" ::: "memory");
    __syncthreads();
    if (threadIdx.x == 0) {
        __builtin_amdgcn_fence(__ATOMIC_RELEASE, "agent");
        asm volatile("s_waitcnt vmcnt(0)" ::: "memory");
        int z; asm volatile("v_mov_b32 %0, 0" : "=v"(z));
        __hip_atomic_fetch_add(cnt + z, 1u, __ATOMIC_RELAXED, __HIP_MEMORY_SCOPE_AGENT);
        while (__hip_atomic_load(cnt, __ATOMIC_RELAXED, __HIP_MEMORY_SCOPE_AGENT) < target) __builtin_amdgcn_s_sleep(2);
        __builtin_amdgcn_fence(__ATOMIC_ACQUIRE, "agent");
        asm volatile("s_waitcnt vmcnt(0)" ::: "memory");
    }
    __syncthreads();
}

struct Args { const float* in[13]; float* out; unsigned char* ws; int ph_lo, ph_hi; };

__device__ __forceinline__ int src_col(int n) {
    const bool r = (n < C_AV) || (n >= C_BQ && n < C_BV);
    if (!r) return n;
    const int w = n & 63;
    return (n & ~63) + (w >> 1) + 32 * (w & 1);
}
__device__ __forceinline__ void transpose_item(const float* __restrict__ W, int N, bf16_t* __restrict__ WT, LAS float* scr, int item, int lane, bool permute) {
    const int nblk = N / 32, kb = item / nblk, nb = item % nblk, k0 = 64 * kb, n0 = 32 * nb;
    const int sc = permute ? src_col(n0 + (lane & 31)) : n0 + (lane & 31);
#pragma unroll 8
    for (int i = 0; i < 32; ++i) { const int kk = 2 * i + (lane >> 5); scr[kk * 33 + (lane & 31)] = W[(size_t)(k0 + kk) * N + sc]; }
    asm volatile("s_waitcnt lgkmcnt(0)" ::: "memory");
    const int c = lane & 7;
#pragma unroll
    for (int j = 0; j < 4; ++j) {
        const int n = (lane >> 3) + 8 * j; const LAS float* s = scr + (8 * c) * 33 + n;
        const int nn = n0 + n; const float sc = (permute && (nn < C_AK || (nn >= C_BQ && nn < C_BK))) ? 0.125f * 1.4426950408889634f : 1.0f;
        u32x4 o; o.x = cvtpk(s[0 * 33] * sc, s[1 * 33] * sc); o.y = cvtpk(s[2 * 33] * sc, s[3 * 33] * sc); o.z = cvtpk(s[4 * 33] * sc, s[5 * 33] * sc); o.w = cvtpk(s[6 * 33] * sc, s[7 * 33] * sc);
        *(u32x4*)(WT + (size_t)nn * 1024 + k0 + 8 * c) = o;
    }
    asm volatile("s_waitcnt lgkmcnt(0)" ::: "memory");
}

__device__ __forceinline__ const float* h0_row(const Args& a, int g, int b, int pos) {
    if (pos < 16) return a.in[2] + (size_t)pos * DM;
    return (g ? a.in[1] : a.in[0]) + ((size_t)b * (g ? SS : SP) + (pos - 16)) * DM;
}

__device__ __forceinline__ void prologue(const Args& a, LAS unsigned char* lds) {
    int tid_ = threadIdx.x; asm volatile("" : "+v"(tid_));
    const int tid = tid_, lane = tid & 63, wave = tid >> 6;
    const int gw = blockIdx.x * NWAVES + wave, NGW = gridDim.x * NWAVES;
    unsigned char* ws = a.ws;
    LAS float* scr = (LAS float*)(lds + wave * 16384);
    constexpr int I_IN = 16 * (NIN / 32), I_OUT = 16 * (DM / 32);
    constexpr int NITEMS = DEPTH * (I_IN + I_OUT);
    for (int it = gw; it < NITEMS; it += NGW) {
        if (it < DEPTH * I_IN) { const int l = it / I_IN, r = it - l * I_IN;
            transpose_item(a.in[3] + (size_t)l * DM * NIN, NIN, (bf16_t*)(ws + WS_WIN) + (size_t)l * NIN * DM, scr, r, lane, true); }
        else { const int q = it - DEPTH * I_IN, l = q / I_OUT, r = q - l * I_OUT;
            transpose_item(a.in[4] + (size_t)l * DM * DM, DM, (bf16_t*)(ws + WS_WOUT) + (size_t)l * DM * DM, scr, r, lane, false); }
    }
    {
        f32x2* rope = (f32x2*)(ws + WS_ROPE);
        for (int e = blockIdx.x * 512 + tid; e < LP * 32; e += gridDim.x * 512) {
            const int pos = e >> 5, i = e & 31;
            const float inv_freq = __builtin_amdgcn_exp2f(-(float)i * (13.287712379549449f / 32.0f));
            const float ang = (float)pos * inv_freq;
            const float rev = ang * 0.15915494309189535f;
            const float fr = rev - floorf(rev);
            f32x2 cs; cs.x = __builtin_amdgcn_cosf(fr); cs.y = __builtin_amdgcn_sinf(fr);
            rope[e] = cs;
        }
    }
    {
        const float* pg = a.in[5];
        bf16_t* hn = (bf16_t*)(ws + WS_HN);
        for (int row0 = gw; row0 < MROWS; row0 += 2 * NGW) {
            f32x4 v[2][4]; bool live[2]; int rows[2];
#pragma unroll
            for (int u = 0; u < 2; ++u) {
                const int row = row0 + u * NGW; live[u] = row < MROWS; rows[u] = live[u] ? row : MROWS - 1;
                int g, b, pos; row_decode(rows[u], g, b, pos);
                const float* x = h0_row(a, g, b, pos);
#pragma unroll
                for (int j = 0; j < 2; ++j) { v[u][2 * j] = *(const f32x4*)(x + 512 * j + lane * 8); v[u][2 * j + 1] = *(const f32x4*)(x + 512 * j + lane * 8 + 4); }
            }
#pragma unroll
            for (int u = 0; u < 2; ++u) {
                if (!live[u]) continue;
                float ss = 0.f;
#pragma unroll
                for (int j = 0; j < 4; ++j) ss += (v[u][j][0] * v[u][j][0] + v[u][j][1] * v[u][j][1]) + (v[u][j][2] * v[u][j][2] + v[u][j][3] * v[u][j][3]);
                const float rstd = __builtin_amdgcn_rsqf(wave_sum(ss, lane) * (1.0f / DM) + EPS);
#pragma unroll
                for (int j = 0; j < 2; ++j) {
                    const f32x4 g0 = *(const f32x4*)(pg + 512 * j + lane * 8), g1 = *(const f32x4*)(pg + 512 * j + lane * 8 + 4);
                    const f32x4 a0 = v[u][2 * j] * rstd * g0, a1 = v[u][2 * j + 1] * rstd * g1;
                    u32x4 o; o.x = cvtpk(a0[0], a0[1]); o.y = cvtpk(a0[2], a0[3]); o.z = cvtpk(a1[0], a1[1]); o.w = cvtpk(a1[2], a1[3]);
                    *(u32x4*)(hn + (size_t)rows[u] * DM + 512 * j + lane * 8) = o;
                }
            }
        }
    }
    {
        u32x4* pad = (u32x4*)(ws + WS_PROJ + (size_t)MROWS * NIN * 2);
        const u32x4 z = {0u, 0u, 0u, 0u};
        for (int e = blockIdx.x * 512 + tid; e < (64 * NIN * 2) / 16; e += gridDim.x * 512) pad[e] = z;
    }
    if (blockIdx.x == 0 && wave == 0) {
        float* lamv = (float*)(ws + WS_LAM);
        for (int l = 0; l < DEPTH; ++l) {
            const float s1 = wave_sum(a.in[8][l * 64 + lane] * a.in[9][l * 64 + lane], lane);
            const float s2 = wave_sum(a.in[10][l * 64 + lane] * a.in[11][l * 64 + lane], lane);
            const float li = 0.8f - 0.6f * expf(-0.3f * (float)l);
            if (lane == 0) { lamv[2 * l] = expf(s1) - expf(s2) + li; lamv[2 * l + 1] = 1.0f - li; }
        }
    }
}

struct NormRow { const float* hold; float* hnew; u32x4 r[2]; f32x4 ho[4]; bool live; bool meta; };
__device__ __forceinline__ void norm_load(const Args& a, int l, bool last, int row, int lane, const bf16_t* ob, float* metah, NormRow& R) {
    R.live = row < MROWS;
    const int rr = R.live ? row : MROWS - 1;
    int g, b, pos; row_decode(rr, g, b, pos);
    if (last && pos < 16) R.live = false;
    R.meta = pos < 16;
    if (pos < 16) { R.hnew = metah + ((size_t)(g * NB + b) * 16 + pos) * DM; R.hold = (l == 0) ? a.in[2] + (size_t)pos * DM : R.hnew; }
    else { const size_t off = (g ? (size_t)NB * SP * DM : 0) + ((size_t)b * (g ? SS : SP) + (pos - 16)) * DM; R.hnew = a.out + off;
           R.hold = (l == 0) ? (g ? a.in[1] : a.in[0]) + ((size_t)b * (g ? SS : SP) + (pos - 16)) * DM : R.hnew; }
#pragma unroll
    for (int j = 0; j < 2; ++j) R.r[j] = *(const u32x4*)(ob + (size_t)rr * DM + 512 * j + lane * 8);
    if (l == 0 || R.meta) {
#pragma unroll
        for (int j = 0; j < 4; ++j) R.ho[j] = *(const f32x4*)(R.hold + 512 * (j >> 1) + lane * 8 + 4 * (j & 1));
    } else {
        const bf16_t* hb = (const bf16_t*)R.hold;
#pragma unroll
        for (int j = 0; j < 2; ++j) {
            const u32x4 q = *(const u32x4*)(hb + 512 * j + lane * 8);
            R.ho[2 * j] = (f32x4){bf_lo(q.x), bf_hi(q.x), bf_lo(q.y), bf_hi(q.y)};
            R.ho[2 * j + 1] = (f32x4){bf_lo(q.z), bf_hi(q.z), bf_lo(q.w), bf_hi(q.w)};
        }
    }
}
__device__ __forceinline__ void norm_compute(const NormRow& R, int row, int lane, bool last, const f32x4 (&pgv)[4], const f32x4 (&prv)[4], bf16_t* hn) {
    if (!R.live) return;
    f32x4 ov[4]; float ss = 0.f;
#pragma unroll
    for (int j = 0; j < 2; ++j) {
        const u32x4 r = R.r[j];
        ov[2 * j] = (f32x4){bf_lo(r.x), bf_hi(r.x), bf_lo(r.y), bf_hi(r.y)};
        ov[2 * j + 1] = (f32x4){bf_lo(r.z), bf_hi(r.z), bf_lo(r.w), bf_hi(r.w)};
    }
#pragma unroll
    for (int j = 0; j < 4; ++j) ss += (ov[j][0] * ov[j][0] + ov[j][1] * ov[j][1]) + (ov[j][2] * ov[j][2] + ov[j][3] * ov[j][3]);
    const float rstd = __builtin_amdgcn_rsqf(wave_sum(ss, lane) * (1.0f / DM) + EPS);
    f32x4 hv[4]; float s2 = 0.f;
#pragma unroll
    for (int j = 0; j < 4; ++j) {
        const int c0 = 512 * (j >> 1) + lane * 8 + 4 * (j & 1);
        hv[j] = R.ho[j] + ov[j] * rstd * pgv[j];
        s2 += (hv[j][0] * hv[j][0] + hv[j][1] * hv[j][1]) + (hv[j][2] * hv[j][2] + hv[j][3] * hv[j][3]);
    }
    if (last || R.meta) {
#pragma unroll
        for (int j = 0; j < 4; ++j) { if (last) __builtin_nontemporal_store(hv[j], (f32x4*)(R.hnew + 512 * (j >> 1) + lane * 8 + 4 * (j & 1))); else *(f32x4*)(R.hnew + 512 * (j >> 1) + lane * 8 + 4 * (j & 1)) = hv[j]; }
    } else {
        bf16_t* hb = (bf16_t*)R.hnew;
#pragma unroll
        for (int j = 0; j < 2; ++j) {
            u32x4 o; o.x = cvtpk(hv[2 * j][0], hv[2 * j][1]); o.y = cvtpk(hv[2 * j][2], hv[2 * j][3]); o.z = cvtpk(hv[2 * j + 1][0], hv[2 * j + 1][1]); o.w = cvtpk(hv[2 * j + 1][2], hv[2 * j + 1][3]);
            __builtin_nontemporal_store(o, (u32x4*)(hb + 512 * j + lane * 8));
        }
    }
    if (!last) {
        const float rstd2 = __builtin_amdgcn_rsqf(wave_sum(s2, lane) * (1.0f / DM) + EPS);
#pragma unroll
        for (int j = 0; j < 2; ++j) {
            const int c0 = 512 * j + lane * 8;
            const f32x4 a0 = hv[2 * j] * rstd2 * prv[2 * j], a1 = hv[2 * j + 1] * rstd2 * prv[2 * j + 1];
            u32x4 o; o.x = cvtpk(a0[0], a0[1]); o.y = cvtpk(a0[2], a0[3]); o.z = cvtpk(a1[0], a1[1]); o.w = cvtpk(a1[2], a1[3]);
            *(u32x4*)(hn + (size_t)row * DM + c0) = o;
        }
    }
}
__device__ __forceinline__ void norm_phase(const Args& a, int l) {
    int tid_ = threadIdx.x; asm volatile("" : "+v"(tid_));
    const int tid = tid_, lane = tid & 63, wave = tid >> 6;
    const int gw = blockIdx.x * NWAVES + wave, NGW = gridDim.x * NWAVES;
    unsigned char* ws = a.ws;
    const bf16_t* ob = (const bf16_t*)(ws + WS_PROJ);
    bf16_t* hn = (bf16_t*)(ws + WS_HN);
    float* metah = (float*)(ws + WS_METAH);
    const float* postg = a.in[6] + (size_t)l * DM;
    const bool last = (l == DEPTH - 1);
    const float* preg = a.in[5] + (size_t)(last ? l : l + 1) * DM;
    f32x4 pgv[4], prv[4];
#pragma unroll
    for (int j = 0; j < 4; ++j) { const int c0 = 512 * (j >> 1) + lane * 8 + 4 * (j & 1); pgv[j] = *(const f32x4*)(postg + c0); prv[j] = *(const f32x4*)(preg + c0); }
    for (int row = gw; row < MROWS; row += 2 * NGW) {
        NormRow A, B;
        norm_load(a, l, last, row, lane, ob, metah, A);
        norm_load(a, l, last, row + NGW, lane, ob, metah, B);
        norm_compute(A, row, lane, last, pgv, prv, hn);
        norm_compute(B, row + NGW, lane, last, pgv, prv, hn);
    }
}

__global__ void __launch_bounds__(NWAVES * 64, 2) fwd_kernel(Args a) {
    extern __shared__ __attribute__((aligned(16))) unsigned char lds_raw[];
    LAS unsigned char* lds = (LAS unsigned char*)lds_raw;
    unsigned char* ws = a.ws;
#define IN(k) true
#define SEAM(k) do { ++nbar; grid_bar((unsigned*)(ws + WS_CTL) + 1024, nbar * gridDim.x); } while (0)
    unsigned nbar = 0;
    if (IN(0)) { prologue(a, lds); }
    cg::this_grid().sync();
    for (int l = 0; l < DEPTH; ++l) {
        const int p0 = 1 + 4 * l;
        if (IN(p0)) {
            pg8::Gemm g{(const bf16_t*)(ws + WS_HN), (const bf16_t*)(ws + WS_WIN) + (size_t)l * NIN * DM, MROWS, NIN, DM};
            pg8::StaticOrder S; S.init(MROWS, NIN, (int)gridDim.x, (int)blockIdx.x);
            pg8::EpiStore<true> E{(bf16_t*)(ws + WS_PROJ), NIN, (const f32x2*)(ws + WS_ROPE)};
            pg8::gemm_phase<pg8::EpiStore<true>, pg8::StaticOrder, true, true>(lds, g, S, E);
        }
        SEAM(p0);
        if (IN(p0 + 1)) {
            att::attn_phase(lds, (const bf16_t*)(ws + WS_PROJ), (bf16_t*)(ws + WS_HN), (float*)(ws + WS_STASH), (unsigned*)(ws + WS_CTL) + 2048 + 512 * l, l == DEPTH - 1,
                            (const float*)(ws + WS_LAM) + 2 * l, a.in[12] + (size_t)l * 128, a.in[7] + (size_t)l * 8);
        }
        SEAM(p0 + 1);
        if (IN(p0 + 2)) {
            pg8::Gemm g{(const bf16_t*)(ws + WS_HN), (const bf16_t*)(ws + WS_WOUT) + (size_t)l * DM * DM, MROWS, DM, DM};
            pg8::StaticOrder S; S.init(MROWS, DM, (int)gridDim.x, (int)blockIdx.x);
            pg8::EpiStore<false> E{(bf16_t*)(ws + WS_PROJ), DM, nullptr};
            pg8::gemm_phase<pg8::EpiStore<false>, pg8::StaticOrder, true, true>(lds, g, S, E);
        }
        SEAM(p0 + 2);
        if (IN(p0 + 3)) norm_phase(a, l);
        SEAM(p0 + 3);
    }
#undef IN
#undef SEAM
}

extern "C" void kernel_launch(void* const* d_in, const int* in_sizes, int n_in, void* d_out, int out_size, void* d_ws, size_t ws_size, hipStream_t stream) {
    static int grid = 0;
    if (grid == 0) {
        if (n_in != 13 || ws_size < WS_END) { fprintf(stderr, "kernel_launch: need 13 inputs and >= %zu bytes of workspace; got %d, %zu\n", (size_t)WS_END, n_in, ws_size); grid = -1; return; }
        int dev = 0, cus = 0, per_cu = 0;
        if (hipGetDevice(&dev) != hipSuccess || hipDeviceGetAttribute(&cus, hipDeviceAttributeMultiprocessorCount, dev) != hipSuccess) { grid = -1; return; }
        if (hipFuncSetAttribute((const void*)fwd_kernel, hipFuncAttributeMaxDynamicSharedMemorySize, LDS_BYTES) != hipSuccess) { fprintf(stderr, "kernel_launch: hipFuncSetAttribute failed\n"); grid = -1; return; }
        if (hipOccupancyMaxActiveBlocksPerMultiprocessor(&per_cu, (const void*)fwd_kernel, NWAVES * 64, LDS_BYTES) != hipSuccess || per_cu < 1) { fprintf(stderr, "kernel_launch: occupancy query says %d\n", per_cu); per_cu = 1; }
        (void)hipGetLastError();
        grid = cus * 1;
    }
    if (grid < 0) return;
    (void)hipMemsetAsync((char*)d_ws + WS_CTL, 0, CTL_BYTES, stream);
    Args a{};
    for (int i = 0; i < 13; ++i) a.in[i] = (const float*)d_in[i];
    a.out = (float*)d_out; a.ws = (unsigned char*)d_ws; a.ph_lo = 0; a.ph_hi = N_PHASES;
    void* args[] = {&a};
    hipError_t e = hipLaunchCooperativeKernel((const void*)fwd_kernel, dim3(grid), dim3(NWAVES * 64), args, LDS_BYTES, stream);
    if (e != hipSuccess) fprintf(stderr, "cooperative launch failed: %s (grid %d)\n", hipGetErrorString(e), grid);
}
```
